# Optimizing an MI355X kernel written in HIP

```python
import math
import jax, jax.numpy as jnp
from jax import lax
import numpy as np

D_MODEL = 1024
BATCH = 16
SEQ = 256
DEPTH = 2
DEC_BATCH = 4
DEC_SEQ = 4096
PAST_LEN = 256

GRID_W = 64
HEAD_DIM = 64
NA_HEADS = 8
NA_WIDTH = NA_HEADS * HEAD_DIM
WIN_H = 8
WIN_W = 16
SSM_WIDTH = D_MODEL - NA_WIDTH
SSM_GROUP = 16
SSM_GROUPS = SSM_WIDTH // SSM_GROUP
SSM_STATE = 64
GQA_HEADS = 16
GQA_KV_HEADS = 4
ROPE_THETA = 10000.0
D_FF = 2816
Q_BLOCK = 128
EPS = 1e-6
N_EVEN = (DEPTH + 1) // 2
N_ODD = DEPTH // 2
EVEN_IN = 3 * NA_WIDTH + SSM_WIDTH
ODD_IN = (GQA_HEADS + 2 * GQA_KV_HEADS) * HEAD_DIM

kernel_name = 'hybrid_natten_s5_gqa_diffusion_step'


def rmsnorm(x, g):
    xf = x.astype(jnp.float32)
    xf = xf * lax.rsqrt(jnp.mean(xf * xf, axis=-1, keepdims=True) + EPS)
    return (xf * g.astype(jnp.float32)).astype(x.dtype)


def adaln(cvec, w, b):
    m = jnp.dot(jax.nn.silu(cvec), w) + b
    return jnp.split(m[..., None, :], 6, axis=-1)


def modulate(h, shift, scale):
    return h * (1 + scale) + shift


def rope_2d(x):
    L = x.shape[1]
    t = jnp.arange(L)
    half = HEAD_DIM // 2
    nf = half // 2
    freqs = ROPE_THETA ** (-jnp.arange(nf, dtype=jnp.float32) / nf)

    def rotate(xh, pos):
        ang = pos.astype(jnp.float32)[:, None] * freqs[None, :]
        cos = jnp.cos(ang)[None, :, None, :]
        sin = jnp.sin(ang)[None, :, None, :]
        x1, x2 = xh[..., :nf], xh[..., nf:]
        return jnp.concatenate([x1 * cos - x2 * sin, x1 * sin + x2 * cos], axis=-1)

    xf = x.astype(jnp.float32)
    out = jnp.concatenate([rotate(xf[..., :half], t // GRID_W), rotate(xf[..., half:], t % GRID_W)], axis=-1)
    return out.astype(x.dtype)


def blocked_attention(q, k, v):
    B, S, H, Dh = q.shape
    Hkv = k.shape[2]
    G = H // Hkv
    nb = S // Q_BLOCK
    qb = q.reshape(B, nb, Q_BLOCK, Hkv, G, Dh).transpose(1, 0, 2, 3, 4, 5)
    scale = Dh ** -0.5

    def block(qi):
        s = jnp.einsum('bqkgd,btkd->bkgqt', qi, k, preferred_element_type=jnp.float32) * scale
        p = jax.nn.softmax(s, axis=-1).astype(v.dtype)
        return jnp.einsum('bkgqt,btkd->bqkgd', p, v)

    o = lax.map(block, qb)
    return o.transpose(1, 0, 2, 3, 4, 5).reshape(B, S, H, Dh)


def na_latent(q, k, v, k_ctx, v_ctx, rpb):
    B, L, H, Dh = q.shape
    rows = L // GRID_W
    kh = min(WIN_H, rows)
    kw = WIN_W
    qg = q.reshape(B, rows, GRID_W, H, Dh)
    kg = k.reshape(B, rows, GRID_W, H, Dh)
    vg = v.reshape(B, rows, GRID_W, H, Dh)
    cols = jnp.arange(GRID_W)
    col_start = jnp.clip(cols - kw // 2, 0, GRID_W - kw)
    col_idx = col_start[:, None] + jnp.arange(kw)[None, :]
    dc = col_idx - cols[:, None] + (WIN_W - 1)
    rpb_f = rpb.astype(jnp.float32)
    scale = Dh ** -0.5

    def row_fn(r):
        rs = jnp.clip(r - kh // 2, 0, rows - kh)
        q_r = lax.dynamic_index_in_dim(qg, r, axis=1, keepdims=False)
        k_band = lax.dynamic_slice_in_dim(kg, rs, kh, axis=1)
        v_band = lax.dynamic_slice_in_dim(vg, rs, kh, axis=1)
        k_win = k_band[:, :, col_idx]
        v_win = v_band[:, :, col_idx]
        s_loc = jnp.einsum('bwhd,biwjhd->bhwij', q_r, k_win, preferred_element_type=jnp.float32) * scale
        dr = rs + jnp.arange(kh) - r + (WIN_H - 1)
        bias = rpb_f[:, dr[None, :, None], dc[:, None, :]]
        s_loc = s_loc + bias[None]
        s_ctx = jnp.einsum('bwhd,blhd->bhwl', q_r, k_ctx, preferred_element_type=jnp.float32) * scale
        s = jnp.concatenate([s_loc.reshape(B, H, GRID_W, kh * kw), s_ctx], axis=-1)
        p = jax.nn.softmax(s, axis=-1).astype(v.dtype)
        p_loc = p[..., :kh * kw].reshape(B, H, GRID_W, kh, kw)
        p_ctx = p[..., kh * kw:]
        return (jnp.einsum('bhwij,biwjhd->bwhd', p_loc, v_win)
                + jnp.einsum('bhwl,blhd->bwhd', p_ctx, v_ctx))

    out = lax.map(row_fn, jnp.arange(rows))
    return out.transpose(1, 0, 2, 3, 4).reshape(B, L, H, Dh)


def zoh(a_re, a_im, log_dt, b_re, b_im):
    a_re = a_re.astype(jnp.float32)
    a_im = a_im.astype(jnp.float32)
    b_re = b_re.astype(jnp.float32)
    b_im = b_im.astype(jnp.float32)
    dt = jnp.exp(log_dt.astype(jnp.float32))[:, None]
    mag = jnp.exp(a_re * dt)
    abr = mag * jnp.cos(a_im * dt)
    abi = mag * jnp.sin(a_im * dt)
    den = a_re * a_re + a_im * a_im
    nr = abr - 1.0
    ni = abi
    kr = (nr * a_re + ni * a_im) / den
    ki = (ni * a_re - nr * a_im) / den
    bbr = kr[..., None] * b_re - ki[..., None] * b_im
    bbi = kr[..., None] * b_im + ki[..., None] * b_re
    return abr, abi, bbr, bbi


def _complex_affine_combine(e1, e2):
    a1r, a1i, b1r, b1i = e1
    a2r, a2i, b2r, b2i = e2
    return (a2r * a1r - a2i * a1i,
            a2r * a1i + a2i * a1r,
            a2r * b1r - a2i * b1i + b2r,
            a2r * b1i + a2i * b1r + b2i)


def diag_scan(abr, abi, bur, bui, h0, reverse):
    L = bur.shape[1]
    ar = jnp.broadcast_to(abr, (1, L) + abr.shape)
    ai = jnp.broadcast_to(abi, (1, L) + abi.shape)
    Ar, Ai, Hr, Hi = lax.associative_scan(_complex_affine_combine, (ar, ai, bur, bui), reverse=reverse, axis=1)
    if h0 is not None:
        h0r = h0[0][:, None]
        h0i = h0[1][:, None]
        Hr = Hr + Ar * h0r - Ai * h0i
        Hi = Hi + Ar * h0i + Ai * h0r
    return Hr, Hi


def s5_mixer(u, ssm, init):
    a_re, a_im, log_dt, b_re, b_im, c_re, c_im, d, w_glu, b_glu = ssm
    B, L, _ = u.shape
    uf = u.astype(jnp.float32).reshape(B, L, SSM_GROUPS, SSM_GROUP)
    y = uf * d.astype(jnp.float32)
    finals = []
    for dr in range(2):
        rev = dr == 1
        abr, abi, bbr, bbi = zoh(a_re[dr], a_im[dr], log_dt[dr], b_re[dr], b_im[dr])
        bur = jnp.einsum('blgc,gpc->blgp', uf, bbr)
        bui = jnp.einsum('blgc,gpc->blgp', uf, bbi)
        h0 = None if init is None else (init[0][:, dr].astype(jnp.float32), init[1][:, dr].astype(jnp.float32))
        hr, hi = diag_scan(abr, abi, bur, bui, h0, rev)
        y = (y + jnp.einsum('gcp,blgp->blgc', c_re[dr].astype(jnp.float32), hr)
             - jnp.einsum('gcp,blgp->blgc', c_im[dr].astype(jnp.float32), hi))
        if init is None:
            end = 0 if rev else L - 1
            finals.append((hr[:, end], hi[:, end]))
    y = jax.nn.gelu(y.reshape(B, L, SSM_WIDTH))
    y = y * jax.nn.sigmoid(y @ w_glu.astype(jnp.float32) + b_glu.astype(jnp.float32))
    y = y.astype(u.dtype)
    if init is None:
        s_re = jnp.stack([f[0] for f in finals], axis=1).astype(u.dtype)
        s_im = jnp.stack([f[1] for f in finals], axis=1).astype(u.dtype)
        return y, (s_re, s_im)
    return y, None


def even_mixer(h, ev, ctx):
    w_in, w_out, q_g, k_g, rpb = ev[:5]
    ssm = ev[5:]
    B, L, _ = h.shape
    hp = h @ w_in
    q, k, v, u = jnp.split(hp, [NA_WIDTH, 2 * NA_WIDTH, 3 * NA_WIDTH], axis=-1)
    q = rmsnorm(q.reshape(B, L, NA_HEADS, HEAD_DIM), q_g)
    k = rmsnorm(k.reshape(B, L, NA_HEADS, HEAD_DIM), k_g)
    v = v.reshape(B, L, NA_HEADS, HEAD_DIM)
    if ctx is None:
        na = blocked_attention(q, k, v)
        y_ssm, (s_re, s_im) = s5_mixer(u, ssm, None)
        out = jnp.concatenate([na.reshape(B, L, NA_WIDTH), y_ssm], axis=-1) @ w_out
        return out, (k, v, s_re, s_im)
    k_ctx, v_ctx, s_re, s_im = ctx
    na = na_latent(q, k, v, k_ctx, v_ctx, rpb)
    y_ssm, _ = s5_mixer(u, ssm, (s_re, s_im))
    return jnp.concatenate([na.reshape(B, L, NA_WIDTH), y_ssm], axis=-1) @ w_out, None


def odd_mixer(h, od, ctx):
    w_in, w_out, q_g, k_g = od
    B, L, _ = h.shape
    hp = h @ w_in
    q, k, v = jnp.split(hp, [GQA_HEADS * HEAD_DIM, (GQA_HEADS + GQA_KV_HEADS) * HEAD_DIM], axis=-1)
    q = rmsnorm(q.reshape(B, L, GQA_HEADS, HEAD_DIM), q_g)
    k = rmsnorm(k.reshape(B, L, GQA_KV_HEADS, HEAD_DIM), k_g)
    v = v.reshape(B, L, GQA_KV_HEADS, HEAD_DIM)
    if ctx is None:
        o = blocked_attention(q, k, v)
        return o.reshape(B, L, GQA_HEADS * HEAD_DIM) @ w_out, (k, v)
    k_ctx, v_ctx = ctx
    q = rope_2d(q)
    k = rope_2d(k)
    o = blocked_attention(q, jnp.concatenate([k, k_ctx], axis=1), jnp.concatenate([v, v_ctx], axis=1))
    return o.reshape(B, L, GQA_HEADS * HEAD_DIM) @ w_out, None


def dwconv3(x, w, b):
    xp = jnp.pad(x, ((0, 0), (1, 1), (0, 0)))
    return xp[:, :-2] * w[0] + xp[:, 1:-1] * w[1] + xp[:, 2:] * w[2] + b


def conv_ffn(h, w_up, conv_w, conv_b, w_down):
    gate, val = jnp.split(h @ w_up, 2, axis=-1)
    gate = dwconv3(gate, conv_w, conv_b)
    return (jax.nn.silu(gate) * val) @ w_down


def setup_inputs(seed: int = 0) -> dict:
    key = jax.random.key(seed)
    ks = jax.random.split(key, 40)

    def nrm(k, shape, s):
        return jax.random.normal(k, shape, jnp.float32) * s

    G, P, C = SSM_GROUPS, SSM_STATE, SSM_GROUP
    n_idx = jnp.arange(P, dtype=jnp.float32)
    return {
        'x_prompt': nrm(ks[0], (BATCH, SEQ, D_MODEL), 1.0),
        'x_sample': nrm(ks[1], (DEC_BATCH, DEC_SEQ, D_MODEL), 1.0),
        'cache_na_k': nrm(ks[2], (DEC_BATCH, N_EVEN, PAST_LEN, NA_HEADS, HEAD_DIM), 1.0),
        'cache_na_v': nrm(ks[3], (DEC_BATCH, N_EVEN, PAST_LEN, NA_HEADS, HEAD_DIM), 1.0),
        'state_ssm_re': nrm(ks[4], (DEC_BATCH, N_EVEN, 2, G, P), 0.3),
        'state_ssm_im': nrm(ks[5], (DEC_BATCH, N_EVEN, 2, G, P), 0.3),
        'cache_gqa_k': nrm(ks[6], (DEC_BATCH, N_ODD, PAST_LEN, GQA_KV_HEADS, HEAD_DIM), 1.0),
        'cache_gqa_v': nrm(ks[7], (DEC_BATCH, N_ODD, PAST_LEN, GQA_KV_HEADS, HEAD_DIM), 1.0),
        'c': nrm(ks[8], (DEC_BATCH, D_MODEL), 1.0),
        'c_ctx': nrm(ks[9], (D_MODEL,), 1.0),
        'norm1_g': 1.0 + nrm(ks[10], (DEPTH, D_MODEL), 0.02),
        'norm2_g': 1.0 + nrm(ks[11], (DEPTH, D_MODEL), 0.02),
        'ada_w': nrm(ks[12], (DEPTH, D_MODEL, 6 * D_MODEL), D_MODEL ** -0.5),
        'ada_b': nrm(ks[13], (DEPTH, 6 * D_MODEL), 0.01),
        'ffn_w_up': nrm(ks[14], (DEPTH, D_MODEL, 2 * D_FF), D_MODEL ** -0.5),
        'ffn_conv_w': nrm(ks[15], (DEPTH, 3, D_FF), 3 ** -0.5),
        'ffn_conv_b': nrm(ks[16], (DEPTH, D_FF), 0.01),
        'ffn_w_down': nrm(ks[17], (DEPTH, D_FF, D_MODEL), D_FF ** -0.5),
        'ev_w_in': nrm(ks[18], (N_EVEN, D_MODEL, EVEN_IN), D_MODEL ** -0.5),
        'ev_w_out': nrm(ks[19], (N_EVEN, NA_WIDTH + SSM_WIDTH, D_MODEL), (NA_WIDTH + SSM_WIDTH) ** -0.5),
        'na_q_g': 1.0 + nrm(ks[20], (N_EVEN, HEAD_DIM), 0.02),
        'na_k_g': 1.0 + nrm(ks[21], (N_EVEN, HEAD_DIM), 0.02),
        'na_rpb': nrm(ks[22], (N_EVEN, NA_HEADS, 2 * WIN_H - 1, 2 * WIN_W - 1), 0.02),
        'ssm_a_re': -0.5 + nrm(ks[23], (N_EVEN, 2, G, P), 0.01),
        'ssm_a_im': math.pi * n_idx + nrm(ks[24], (N_EVEN, 2, G, P), 0.01),
        'ssm_log_dt': jax.random.uniform(ks[25], (N_EVEN, 2, G), jnp.float32, math.log(1e-3), math.log(1e-1)),
        'ssm_b_re': nrm(ks[26], (N_EVEN, 2, G, P, C), (2 * C) ** -0.5),
        'ssm_b_im': nrm(ks[27], (N_EVEN, 2, G, P, C), (2 * C) ** -0.5),
        'ssm_c_re': nrm(ks[28], (N_EVEN, 2, G, C, P), (2 * P) ** -0.5),
        'ssm_c_im': nrm(ks[29], (N_EVEN, 2, G, C, P), (2 * P) ** -0.5),
        'ssm_d': nrm(ks[30], (N_EVEN, G, C), 1.0),
        'ssm_w_glu': nrm(ks[31], (N_EVEN, SSM_WIDTH, SSM_WIDTH), SSM_WIDTH ** -0.5),
        'ssm_b_glu': nrm(ks[32], (N_EVEN, SSM_WIDTH), 0.01),
        'od_w_in': nrm(ks[33], (N_ODD, D_MODEL, ODD_IN), D_MODEL ** -0.5),
        'od_w_out': nrm(ks[34], (N_ODD, GQA_HEADS * HEAD_DIM, D_MODEL), (GQA_HEADS * HEAD_DIM) ** -0.5),
        'gqa_q_g': 1.0 + nrm(ks[35], (N_ODD, HEAD_DIM), 0.02),
        'gqa_k_g': 1.0 + nrm(ks[36], (N_ODD, HEAD_DIM), 0.02),
    }


def reference(x_prompt, x_sample, cache_na_k, cache_na_v, state_ssm_re, state_ssm_im, cache_gqa_k, cache_gqa_v,
              c, c_ctx, norm1_g, norm2_g, ada_w, ada_b, ffn_w_up, ffn_conv_w, ffn_conv_b, ffn_w_down,
              ev_w_in, ev_w_out, na_q_g, na_k_g, na_rpb, ssm_a_re, ssm_a_im, ssm_log_dt, ssm_b_re, ssm_b_im,
              ssm_c_re, ssm_c_im, ssm_d, ssm_w_glu, ssm_b_glu, od_w_in, od_w_out, gqa_q_g, gqa_k_g):

    def even_params(i):
        return (ev_w_in[i], ev_w_out[i], na_q_g[i], na_k_g[i], na_rpb[i],
                ssm_a_re[i], ssm_a_im[i], ssm_log_dt[i], ssm_b_re[i], ssm_b_im[i],
                ssm_c_re[i], ssm_c_im[i], ssm_d[i], ssm_w_glu[i], ssm_b_glu[i])

    def odd_params(i):
        return (od_w_in[i], od_w_out[i], gqa_q_g[i], gqa_k_g[i])

    def layer(l, x, cond, ctx):
        sh1, sc1, g1, sh2, sc2, g2 = adaln(cond, ada_w[l], ada_b[l])
        h = modulate(rmsnorm(x, norm1_g[l]), sh1, sc1)
        if l % 2 == 0:
            out, cache = even_mixer(h, even_params(l // 2), ctx)
        else:
            out, cache = odd_mixer(h, odd_params(l // 2), ctx)
        x = x + g1 * out
        h = modulate(rmsnorm(x, norm2_g[l]), sh2, sc2)
        x = x + g2 * conv_ffn(h, ffn_w_up[l], ffn_conv_w[l], ffn_conv_b[l], ffn_w_down[l])
        return x, cache

    xp = x_prompt
    na_k, na_v, s_re, s_im, g_k, g_v = [], [], [], [], [], []
    for l in range(DEPTH):
        xp, cache = layer(l, xp, c_ctx, None)
        if l % 2 == 0:
            na_k.append(cache[0]); na_v.append(cache[1]); s_re.append(cache[2]); s_im.append(cache[3])
        else:
            g_k.append(cache[0]); g_v.append(cache[1])
    y_prompt = xp

    xs = x_sample
    for l in range(DEPTH):
        i = l // 2
        if l % 2 == 0:
            ctx = (cache_na_k[:, i], cache_na_v[:, i], state_ssm_re[:, i], state_ssm_im[:, i])
        else:
            ctx = (cache_gqa_k[:, i], cache_gqa_v[:, i])
        xs, _ = layer(l, xs, c, ctx)
    y_sample = xs

    new_na_k = jnp.stack(na_k, axis=1)
    new_na_v = jnp.stack(na_v, axis=1)
    new_ssm_re = jnp.stack(s_re, axis=1)
    new_ssm_im = jnp.stack(s_im, axis=1)
    new_gqa_k = jnp.stack(g_k, axis=1)
    new_gqa_v = jnp.stack(g_v, axis=1)
    return (y_prompt, y_sample, new_na_k, new_na_v, new_ssm_re, new_ssm_im, new_gqa_k, new_gqa_v)
```

```cpp
#include <hip/hip_runtime.h>
#include <hip/hip_cooperative_groups.h>
#include <cstdio>
#include <cstdint>
namespace cg = cooperative_groups;

#ifndef COOP
#define COOP 1
#endif
#ifndef EN
#define EN 0xff
#endif
#define EN_GEMM (EN & 1)
#define EN_ATT (EN & 2)
#define EN_SSM (EN & 4)
#define EN_MISC (EN & 8)

typedef unsigned short bf16_t;
typedef short bf16x8 __attribute__((ext_vector_type(8)));
typedef short s16x4 __attribute__((ext_vector_type(4)));
typedef float f32x4 __attribute__((ext_vector_type(4)));
typedef float f32x2 __attribute__((ext_vector_type(2)));
typedef float f32x16 __attribute__((ext_vector_type(16)));
typedef unsigned u32x4 __attribute__((ext_vector_type(4)));
typedef unsigned u32x2 __attribute__((ext_vector_type(2)));
#define LAS __attribute__((address_space(3)))

constexpr int DM = 1024, NTOK = 20480, NCTX = 4096, DFF = 2816;
constexpr float EPSN = 1e-6f;
constexpr float QSC = 0.125f * 1.4426950408889634f;
constexpr int NTHREADS = 512;
constexpr int LDS_BYTES = 131072 + 256 + 4096;

constexpr size_t O_Y = 0, O_NAK = 20971520, O_NAV = 23068672, O_SRE = 25165824, O_SIM = 25231360, O_GQK = 25296896, O_GQV = 26345472;

constexpr size_t MiB = 1u << 20;
constexpr size_t WS_MOD = 0;
constexpr size_t WS_BAR = 240 * 1024;
constexpr size_t WS_KMAX = 240 * 1024 + 13824;
constexpr size_t WS_ROPE = 256 * 1024;
constexpr size_t WS_SSA = 272 * 1024;
constexpr size_t WS_SSA64 = 304 * 1024;
constexpr size_t WS_BM = 512 * 1024;
constexpr size_t WS_CM = 768 * 1024;
constexpr size_t WS_NAK = 1 * MiB, WS_NAV = 2 * MiB, WS_GQK = 3 * MiB, WS_GQV = 3 * MiB + 512 * 1024;
constexpr size_t WS_END = 4 * MiB;
constexpr size_t WS_WINE = 14 * MiB, WS_WOUTE = 18 * MiB, WS_WGLU = 20 * MiB, WS_WINO = 20 * MiB + 512 * 1024, WS_WOUTO = 23 * MiB + 512 * 1024;
constexpr size_t WS_WUP = 25 * MiB + 512 * 1024;
constexpr size_t WS_WDOWN = 47 * MiB + 512 * 1024;
constexpr size_t WS_H = 59 * MiB;
constexpr size_t WS_GV = 100 * MiB;
constexpr size_t WS_QKV = 100 * MiB;
constexpr size_t WS_U = 160 * MiB;
constexpr size_t WS_YG = 180 * MiB;
constexpr int FFN_SPLIT = 12288;

struct Params {
    const float* in[37];
    float* out;
    unsigned char* ws;
    int ph_lo, ph_hi, use_cg, pad;
};

__device__ __forceinline__ unsigned pk2(float lo, float hi) { unsigned r; asm("v_cvt_pk_bf16_f32 %0, %1, %2" : "=v"(r) : "v"(lo), "v"(hi)); return r; }
__device__ __forceinline__ float bf2f(unsigned short h) { return __uint_as_float(((unsigned)h) << 16); }
__device__ __forceinline__ float bflo(unsigned w) { return __uint_as_float(w << 16); }
__device__ __forceinline__ float bfhi(unsigned w) { return __uint_as_float(w & 0xffff0000u); }
__device__ __forceinline__ float siluf(float x) { return x * __builtin_amdgcn_rcpf(1.0f + __builtin_amdgcn_exp2f(-1.4426950408889634f * x)); }
__device__ __forceinline__ float sigmf(float x) { return __builtin_amdgcn_rcpf(1.0f + __builtin_amdgcn_exp2f(-1.4426950408889634f * x)); }
__device__ __forceinline__ float gelu_tanh(float x) { const float u = 0.7978845608028654f * (x + 0.044715f * x * x * x); const float e = __builtin_amdgcn_exp2f(2.8853900817779268f * u); const float t = 1.0f - 2.0f * __builtin_amdgcn_rcpf(e + 1.0f); return 0.5f * x * (1.0f + t); }
__device__ __forceinline__ int otid() { int t = threadIdx.x; asm volatile("" : "+v"(t)); return t; }
__device__ __forceinline__ int condof(int row) { return row < NCTX ? 0 : 1 + ((row - NCTX) >> 12); }
__device__ __forceinline__ float wave_sum(float v) {
#pragma unroll
    for (int o = 32; o >= 1; o >>= 1) v += __shfl_xor(v, o);
    return v;
}

constexpr int BM = 256, BK = 64, HALF = 128, HT = HALF * BK;
__device__ __forceinline__ int lds_byte(int r, int c) { int st = (r >> 4) * 2 + (c >> 5), rr = r & 15, cc = c & 31, ob = rr * 64 + cc * 2; return st * 1024 + (ob ^ (((ob >> 9) & 1) << 5)); }
__device__ __forceinline__ void stage_rc(int b, int& R, int& C) { int st = b / 1024, sb = b % 1024, swz = sb ^ (((sb >> 9) & 1) << 5); R = (st >> 1) * 16 + swz / 64; C = (st & 1) * 32 + (swz % 64) / 2; }

struct Unit { int pm, pn, rb, ks, sp; };
struct Gemm { const bf16_t* A; const bf16_t* Bt; int lda, K, Kpart; };
struct Order {
    int pm0, nM, nN, ntile, G, c, ovl, ksplit;
    __device__ __forceinline__ bool next(int i, Unit& u) const {
        const int L0 = i * G + c; if (L0 >= ntile * ksplit) return false;
        const int L = L0 % ntile; u.ks = L0 / ntile;
        int wgid = L; { const int q = ntile / 8, r = ntile % 8, xcd = wgid % 8, off = wgid / 8; wgid = (xcd < r ? xcd * (q + 1) : r * (q + 1) + (xcd - r) * q) + off; }
        const int nig = 8 * nN, gid = wgid / nig, fm = gid * 8, gsz = (nM - fm) < 8 ? (nM - fm) : 8;
        u.pm = pm0 + fm + ((wgid % nig) % gsz); u.pn = (wgid % nig) / gsz;
        u.sp = 0;
        if (ovl && u.pm >= 16) { if (u.pm == 80) { u.rb = NCTX + 4063; u.sp = 1; } else { const int q = u.pm - 16, b = q >> 4, i = q & 15; u.rb = NCTX + 4096 * b + 254 * i - 1; } } else u.rb = u.pm * BM;
        return true;
    }
};
constexpr int HTB = HALF * BK * 2;
template <bool GATHER, class Epi>
__device__ __forceinline__ void gemm_phase(const Gemm g, const Order& S, const Epi& E) {
    extern __shared__ __attribute__((aligned(16))) unsigned char smem[];
    LAS unsigned char* lds = (LAS unsigned char*)smem;
    const int tid = otid(), wid = __builtin_amdgcn_readfirstlane(tid >> 6), lane = tid & 63, wr = wid >> 2, wc = wid & 3, fr = lane & 15, fq = lane >> 4;
    const int K = g.K, nt = g.Kpart / BK, lda = g.lda;
    const size_t kpb = (size_t)g.Kpart * 2;
    unsigned voffA[2], voffB[2];
#pragma unroll
    for (int i = 0; i < 2; ++i) { int R, C; stage_rc(tid * 16 + i * 8192, R, C); voffA[i] = (unsigned)(R * lda + C) * 2u; voffB[i] = (unsigned)(R * K + C) * 2u; }
    const size_t kstep = (size_t)(BK * 2);
    const size_t hstepA = (size_t)HALF * lda * 2, hstepB = (size_t)HALF * K * 2;
    const size_t tstepA = 2 * hstepA, tstepB = 2 * hstepB;
    const unsigned ldsw = (unsigned)wid * 1024u;
    const int aoff = lds_byte(wr * 64 + fr, fq * 8), boff = lds_byte(wc * 32 + fr, fq * 8);
#define PG8_SA(b, h) (((b) * 2 + (h)) * HTB)
#define PG8_SB(b, h) ((4 + (b) * 2 + (h)) * HTB)
#define PG8_STAGE(bufoff, gbase, voff) do { _Pragma("unroll") for (int _i = 0; _i < 2; ++_i) \
        __builtin_amdgcn_global_load_lds((const unsigned*)((const char*)(gbase) + (voff)[_i]), (LAS unsigned*)(lds + (bufoff) + ldsw + _i * 8192), 16, 0, 0); } while (0)
#define PG8_LDA(dst, b, h) do { _Pragma("unroll") for (int m = 0; m < 4; ++m) _Pragma("unroll") for (int k = 0; k < 2; ++k) dst[m][k] = *(const LAS bf16x8*)(lds + PG8_SA(b, h) + aoff + m * 2048 + k * 1024); } while (0)
#define PG8_LDB(dst, b, h) do { _Pragma("unroll") for (int n = 0; n < 2; ++n) _Pragma("unroll") for (int k = 0; k < 2; ++k) dst[n][k] = *(const LAS bf16x8*)(lds + PG8_SB(b, h) + boff + n * 2048 + k * 1024); } while (0)
#define PG8_MMA(ai, bj, At, Bt) do { __builtin_amdgcn_s_setprio(1); _Pragma("unroll") for (int m = 0; m < 4; ++m) _Pragma("unroll") for (int n = 0; n < 2; ++n) _Pragma("unroll") for (int k = 0; k < 2; ++k) \
        acc[ai][bj][m][n] = __builtin_amdgcn_mfma_f32_16x16x32_bf16(Bt[n][k], At[m][k], acc[ai][bj][m][n], 0, 0, 0); __builtin_amdgcn_s_setprio(0); } while (0)
#define PG8_WAIT_V(n) asm volatile("s_waitcnt vmcnt(" #n ")" ::: "memory")
#define PG8_WAIT_L(n) asm volatile("s_waitcnt lgkmcnt(" #n ")" ::: "memory")
#define PG8_BAR __builtin_amdgcn_s_barrier()
#define PG8_SCHED __builtin_amdgcn_sched_barrier(0)
    Unit cur, nxt; int ui = 0;
    if (!S.next(0, cur)) return;
    f32x4 acc[2][2][4][2];
#pragma unroll
    for (int a = 0; a < 2; ++a)
#pragma unroll
        for (int b = 0; b < 2; ++b)
#pragma unroll
            for (int m = 0; m < 4; ++m)
#pragma unroll
                for (int n = 0; n < 2; ++n) acc[a][b][m][n] = (f32x4){0.f, 0.f, 0.f, 0.f};
    bf16x8 At[4][2], B0[2][2], B1[2][2];
    const size_t rstepA = (size_t)lda * 2;
    const char* cA = (const char*)g.A + (size_t)cur.rb * rstepA + cur.ks * kpb; const char* cB = (const char*)g.Bt + (size_t)cur.pn * tstepB + cur.ks * kpb;
    unsigned vc[2]; size_t hc = hstepA;
#define PG8_VMAP(dst, hdst, issp) do { hdst = (issp) ? (size_t)8192 * lda * 2 : hstepA; _Pragma("unroll") for (int i_ = 0; i_ < 2; ++i_) { int R_, C_; stage_rc(tid * 16 + i_ * 8192, R_, C_); \
        const int Rm_ = (issp) ? ((R_ >> 6) * 4096 + (R_ & 63)) : R_; dst[i_] = (unsigned)(Rm_ * lda + C_) * 2u; } } while (0)
    PG8_VMAP(vc, hc, (GATHER && cur.sp));
    PG8_STAGE(PG8_SB(0, 0), cB, voffB); PG8_STAGE(PG8_SB(0, 1), cB + hstepB, voffB); PG8_STAGE(PG8_SA(0, 0), cA, vc); PG8_STAGE(PG8_SA(0, 1), cA + hc, vc);
    if (wr == 1) PG8_BAR;
    PG8_WAIT_V(2); PG8_BAR;
    PG8_STAGE(PG8_SB(1, 0), cB + kstep, voffB); PG8_STAGE(PG8_SA(1, 0), cA + kstep, vc); PG8_STAGE(PG8_SB(1, 1), cB + hstepB + kstep, voffB);
    PG8_WAIT_V(6); PG8_BAR;
    for (;;) {
        const bool has_next = S.next(ui + 1, nxt);
        const char* nA = has_next ? (const char*)g.A + (size_t)nxt.rb * rstepA + nxt.ks * kpb : cA; const char* nB = has_next ? (const char*)g.Bt + (size_t)nxt.pn * tstepB + nxt.ks * kpb : cB;
        for (int t = 0; t < nt; t += 2) {
            const bool last = (t == nt - 2);
            unsigned v2[2]; v2[0] = vc[0]; v2[1] = vc[1]; size_t h2 = hc;
            if (GATHER && last && has_next && nxt.sp != cur.sp) PG8_VMAP(v2, h2, nxt.sp);
            const char* a1 = cA + (size_t)(t + 1) * kstep;
            const char* a2 = last ? nA : cA + (size_t)(t + 2) * kstep; const char* b2 = last ? nB : cB + (size_t)(t + 2) * kstep;
            const char* a3 = a2 + kstep; const char* b3 = b2 + kstep;
            PG8_LDB(B0, 0, 0); PG8_LDB(B1, 0, 1); PG8_SCHED; PG8_LDA(At, 0, 0); PG8_STAGE(PG8_SA(1, 1), a1 + hc, vc);
            PG8_WAIT_V(8); PG8_WAIT_L(0); PG8_BAR; PG8_MMA(0, 0, At, B0); PG8_MMA(0, 1, At, B1); PG8_BAR; PG8_SCHED;
            PG8_LDA(At, 0, 1); PG8_STAGE(PG8_SB(0, 0), b2, voffB); PG8_STAGE(PG8_SB(0, 1), b2 + hstepB, voffB); PG8_STAGE(PG8_SA(0, 0), a2, v2);
            PG8_WAIT_V(8); PG8_WAIT_L(0); PG8_BAR; PG8_MMA(1, 0, At, B0); PG8_MMA(1, 1, At, B1); PG8_BAR; PG8_SCHED;
            PG8_LDB(B0, 1, 0); PG8_LDB(B1, 1, 1); PG8_SCHED; PG8_LDA(At, 1, 0); PG8_STAGE(PG8_SA(0, 1), a2 + h2, v2);
            PG8_WAIT_V(8); PG8_WAIT_L(0); PG8_BAR; PG8_MMA(0, 0, At, B0); PG8_MMA(0, 1, At, B1); PG8_BAR; PG8_SCHED;
            PG8_LDA(At, 1, 1); PG8_STAGE(PG8_SB(1, 0), b3, voffB); PG8_STAGE(PG8_SB(1, 1), b3 + hstepB, voffB); PG8_STAGE(PG8_SA(1, 0), a3, v2);
            PG8_WAIT_V(8); PG8_WAIT_L(0); PG8_BAR; PG8_MMA(1, 0, At, B0); PG8_MMA(1, 1, At, B1); PG8_BAR; PG8_SCHED;
        }
        if (wr == 0) PG8_BAR;
        E(acc, cur, cur.rb, cur.pn * BM, wr, wc, fr, fq);
        if (!has_next) break;
#pragma unroll
        for (int a = 0; a < 2; ++a)
#pragma unroll
            for (int b = 0; b < 2; ++b)
#pragma unroll
                for (int m = 0; m < 4; ++m)
#pragma unroll
                    for (int n = 0; n < 2; ++n) acc[a][b][m][n] = (f32x4){0.f, 0.f, 0.f, 0.f};
        cur = nxt; cA = nA; cB = nB; ++ui; if (GATHER) PG8_VMAP(vc, hc, cur.sp);
        if (wr == 1) PG8_BAR;
    }
    PG8_WAIT_V(0);
    PG8_BAR;
    __syncthreads();
}

template <class Epi>
__device__ __forceinline__ void gemm_phase_n128(const Gemm g, const Order& S, const Epi& E) {
    extern __shared__ __attribute__((aligned(16))) unsigned char smem[];
    LAS unsigned char* lds = (LAS unsigned char*)smem;
    const int tid = otid(), wid = __builtin_amdgcn_readfirstlane(tid >> 6), lane = tid & 63, wr = wid >> 2, wc = wid & 3, fr = lane & 15, fq = lane >> 4;
    const int K = g.K, nt = g.Kpart / BK, lda = g.lda;
    const size_t kpb = (size_t)g.Kpart * 2;
    unsigned voffA[2], voffB[2];
#pragma unroll
    for (int i = 0; i < 2; ++i) { int R, C; stage_rc(tid * 16 + i * 8192, R, C); voffA[i] = (unsigned)(R * lda + C) * 2u; voffB[i] = (unsigned)(R * K + C) * 2u; }
    const size_t kstep = (size_t)(BK * 2);
    const size_t hstepA = (size_t)HALF * lda * 2, hstepB = (size_t)HALF * K * 2;
    const size_t tstepA = 2 * hstepA, tstepB = 2 * hstepB;
    const unsigned ldsw = (unsigned)wid * 1024u;
    const int aoff = lds_byte(wr * 64 + fr, fq * 8), boff = lds_byte(wc * 32 + fr, fq * 8);
    Unit cur, nxt; int ui = 0;
    if (!S.next(0, cur)) return;
    f32x4 acc[2][1][4][2];
#pragma unroll
    for (int a = 0; a < 2; ++a)
#pragma unroll
            for (int m = 0; m < 4; ++m)
#pragma unroll
                for (int n = 0; n < 2; ++n) acc[a][0][m][n] = (f32x4){0.f, 0.f, 0.f, 0.f};
    bf16x8 At[4][2], B0[2][2];
    const size_t rstepA = (size_t)lda * 2;
    const char* cA = (const char*)g.A + (size_t)cur.rb * rstepA + cur.ks * kpb; const char* cB = (const char*)g.Bt + (size_t)cur.pn * hstepB + cur.ks * kpb;
    PG8_STAGE(PG8_SB(0, 0), cB, voffB); PG8_STAGE(PG8_SA(0, 0), cA, voffA); PG8_STAGE(PG8_SA(0, 1), cA + hstepA, voffA);
    if (wr == 1) PG8_BAR;
    PG8_WAIT_V(2); PG8_BAR;
    PG8_STAGE(PG8_SB(1, 0), cB + kstep, voffB); PG8_STAGE(PG8_SA(1, 0), cA + kstep, voffA);
    PG8_WAIT_V(4); PG8_BAR;
    for (;;) {
        const bool has_next = S.next(ui + 1, nxt);
        const char* nA = has_next ? (const char*)g.A + (size_t)nxt.rb * rstepA + nxt.ks * kpb : cA; const char* nB = has_next ? (const char*)g.Bt + (size_t)nxt.pn * hstepB + nxt.ks * kpb : cB;
        for (int t = 0; t < nt; t += 2) {
            const bool last = (t == nt - 2);
            const char* a1 = cA + (size_t)(t + 1) * kstep;
            const char* a2 = last ? nA : cA + (size_t)(t + 2) * kstep; const char* b2 = last ? nB : cB + (size_t)(t + 2) * kstep;
            const char* a3 = a2 + kstep; const char* b3 = b2 + kstep;
            PG8_LDB(B0, 0, 0); PG8_SCHED; PG8_LDA(At, 0, 0); PG8_STAGE(PG8_SA(1, 1), a1 + hstepA, voffA);
            PG8_WAIT_V(6); PG8_WAIT_L(0); PG8_BAR; PG8_MMA(0, 0, At, B0); PG8_BAR; PG8_SCHED;
            PG8_LDA(At, 0, 1); PG8_STAGE(PG8_SB(0, 0), b2, voffB); PG8_STAGE(PG8_SA(0, 0), a2, voffA);
            PG8_WAIT_V(6); PG8_WAIT_L(0); PG8_BAR; PG8_MMA(1, 0, At, B0); PG8_BAR; PG8_SCHED;
            PG8_LDB(B0, 1, 0); PG8_SCHED; PG8_LDA(At, 1, 0); PG8_STAGE(PG8_SA(0, 1), a2 + hstepA, voffA);
            PG8_WAIT_V(6); PG8_WAIT_L(0); PG8_BAR; PG8_MMA(0, 0, At, B0); PG8_BAR; PG8_SCHED;
            PG8_LDA(At, 1, 1); PG8_STAGE(PG8_SB(1, 0), b3, voffB); PG8_STAGE(PG8_SA(1, 0), a3, voffA);
            PG8_WAIT_V(6); PG8_WAIT_L(0); PG8_BAR; PG8_MMA(1, 0, At, B0); PG8_BAR; PG8_SCHED;
        }
        if (wr == 0) PG8_BAR;
        E(acc, cur, cur.rb, cur.pn * HALF, wr, wc, fr, fq);
        if (!has_next) break;
#pragma unroll
        for (int a = 0; a < 2; ++a)
#pragma unroll
                for (int m = 0; m < 4; ++m)
#pragma unroll
                    for (int n = 0; n < 2; ++n) acc[a][0][m][n] = (f32x4){0.f, 0.f, 0.f, 0.f};
        cur = nxt; cA = nA; cB = nB; ++ui;
        if (wr == 1) PG8_BAR;
    }
    PG8_WAIT_V(0);
    PG8_BAR;
    __syncthreads();
}

#undef PG8_SA
#undef PG8_SB

typedef f32x4 AccT[2][2][4][2];

struct EpiInEven {
    bf16_t* QKV; bf16_t* U; const float* qg; const float* kg; float* ok; float* ov;
    __device__ __forceinline__ void operator()(AccT& acc, const Unit& u, int brow, int bcol, int wr, int wc, int fr, int fq) const {
        const int hs = (bcol >> 6) + wc;
        const float* g = hs < 8 ? qg : kg;
        f32x4 gv[2][2];
        if (hs < 16) {
#pragma unroll
            for (int bj = 0; bj < 2; ++bj)
#pragma unroll
                for (int n = 0; n < 2; ++n) gv[bj][n] = *(const f32x4*)(g + bj * 32 + n * 16 + fq * 4);
        }
#pragma unroll
        for (int ai = 0; ai < 2; ++ai)
#pragma unroll
            for (int m = 0; m < 4; ++m) {
                const int row = brow + ai * 128 + wr * 64 + m * 16 + fr;
                f32x4 v[2][2];
#pragma unroll
                for (int bj = 0; bj < 2; ++bj)
#pragma unroll
                    for (int n = 0; n < 2; ++n) v[bj][n] = acc[ai][bj][m][n];
                if (hs < 16) {
                    float ss = 0.f;
#pragma unroll
                    for (int bj = 0; bj < 2; ++bj)
#pragma unroll
                        for (int n = 0; n < 2; ++n) ss += v[bj][n][0] * v[bj][n][0] + v[bj][n][1] * v[bj][n][1] + v[bj][n][2] * v[bj][n][2] + v[bj][n][3] * v[bj][n][3];
                    ss += __shfl_xor(ss, 16); ss += __shfl_xor(ss, 32);
                    const float rstd = rsqrtf(ss * (1.0f / 64.0f) + EPSN);
#pragma unroll
                    for (int bj = 0; bj < 2; ++bj)
#pragma unroll
                        for (int n = 0; n < 2; ++n) v[bj][n] = v[bj][n] * rstd * gv[bj][n] * (hs < 8 ? QSC : 1.0f);
                }
#pragma unroll
                for (int bj = 0; bj < 2; ++bj)
#pragma unroll
                    for (int n = 0; n < 2; ++n) {
                        const int d = bj * 32 + n * 16 + fq * 4;
                        u32x2 w; w.x = pk2(v[bj][n][0], v[bj][n][1]); w.y = pk2(v[bj][n][2], v[bj][n][3]);
                        if (hs < 24) *(u32x2*)(QKV + (size_t)row * 1536 + hs * 64 + d) = w;
                        else *(u32x2*)(U + (size_t)row * 512 + (hs - 24) * 64 + d) = w;
                        if (row < NCTX) {
                            if (hs >= 8 && hs < 16) *(f32x4*)(ok + (size_t)row * 512 + (hs - 8) * 64 + d) = v[bj][n];
                            else if (hs >= 16 && hs < 24) *(f32x4*)(ov + (size_t)row * 512 + (hs - 16) * 64 + d) = v[bj][n];
                        }
                    }
            }
    }
};

struct EpiInOdd {
    bf16_t* QKV; const float* qg; const float* kg; const float* rope; float* ok; float* ov;
    __device__ __forceinline__ void operator()(AccT& acc, const Unit& u, int brow, int bcol, int wr, int wc, int fr, int fq) const {
        const int hs = (bcol >> 6) + wc;
        const float* g = hs < 16 ? qg : kg;
        f32x4 gv[2][2];
        if (hs < 20) {
#pragma unroll
            for (int bj = 0; bj < 2; ++bj)
#pragma unroll
                for (int n = 0; n < 2; ++n) gv[bj][n] = *(const f32x4*)(g + bj * 32 + n * 16 + fq * 4);
        }
#pragma unroll
        for (int ai = 0; ai < 2; ++ai)
#pragma unroll
            for (int m = 0; m < 4; ++m) {
                const int row = brow + ai * 128 + wr * 64 + m * 16 + fr;
                f32x4 v[2][2];
#pragma unroll
                for (int bj = 0; bj < 2; ++bj)
#pragma unroll
                    for (int n = 0; n < 2; ++n) v[bj][n] = acc[ai][bj][m][n];
                if (hs < 20) {
                    float ss = 0.f;
#pragma unroll
                    for (int bj = 0; bj < 2; ++bj)
#pragma unroll
                        for (int n = 0; n < 2; ++n) ss += v[bj][n][0] * v[bj][n][0] + v[bj][n][1] * v[bj][n][1] + v[bj][n][2] * v[bj][n][2] + v[bj][n][3] * v[bj][n][3];
                    ss += __shfl_xor(ss, 16); ss += __shfl_xor(ss, 32);
                    const float rstd = rsqrtf(ss * (1.0f / 64.0f) + EPSN);
#pragma unroll
                    for (int bj = 0; bj < 2; ++bj)
#pragma unroll
                        for (int n = 0; n < 2; ++n) v[bj][n] = v[bj][n] * rstd * gv[bj][n];
                    if (row >= NCTX) {
                        const int t = (row - NCTX) & 4095;
#pragma unroll
                        for (int bj = 0; bj < 2; ++bj) {
                            const int pos = bj == 0 ? (t >> 6) : (t & 63);
                            const float* rp = rope + (pos * 16 + fq * 4) * 2;
                            const f32x4 cs0 = *(const f32x4*)rp, cs1 = *(const f32x4*)(rp + 4);
                            const f32x4 cc = (f32x4){cs0[0], cs0[2], cs1[0], cs1[2]}, sn = (f32x4){cs0[1], cs0[3], cs1[1], cs1[3]};
#pragma unroll
                            for (int j = 0; j < 4; ++j) {
                                const float x1 = v[bj][0][j], x2 = v[bj][1][j];
                                v[bj][0][j] = x1 * cc[j] - x2 * sn[j];
                                v[bj][1][j] = x1 * sn[j] + x2 * cc[j];
                            }
                        }
                    }
                    if (hs < 16) {
#pragma unroll
                        for (int bj = 0; bj < 2; ++bj)
#pragma unroll
                            for (int n = 0; n < 2; ++n) v[bj][n] = v[bj][n] * QSC;
                    }
                }
#pragma unroll
                for (int bj = 0; bj < 2; ++bj)
#pragma unroll
                    for (int n = 0; n < 2; ++n) {
                        const int d = bj * 32 + n * 16 + fq * 4;
                        u32x2 w; w.x = pk2(v[bj][n][0], v[bj][n][1]); w.y = pk2(v[bj][n][2], v[bj][n][3]);
                        *(u32x2*)(QKV + (size_t)row * 1536 + hs * 64 + d) = w;
                        if (row < NCTX) {
                            if (hs >= 16 && hs < 20) *(f32x4*)(ok + (size_t)row * 256 + (hs - 16) * 64 + d) = v[bj][n];
                            else if (hs >= 20) *(f32x4*)(ov + (size_t)row * 256 + (hs - 20) * 64 + d) = v[bj][n];
                        }
                    }
            }
    }
};

struct EpiResid {
    const float* xin_ctx; const float* xin_lat; float* xout; const float* mod; int goff;
    __device__ __forceinline__ void operator()(AccT& acc, const Unit& u, int brow, int bcol, int wr, int wc, int fr, int fq) const {
#pragma unroll
        for (int ai = 0; ai < 2; ++ai)
#pragma unroll
            for (int m = 0; m < 4; ++m) {
                const int row = brow + ai * 128 + wr * 64 + m * 16 + fr;
                const float* xi = row < NCTX ? xin_ctx + (size_t)row * DM : xin_lat + (size_t)(row - NCTX) * DM;
                const float* gp = mod + condof(row) * 6144 + goff;
#pragma unroll
                for (int bj = 0; bj < 2; ++bj)
#pragma unroll
                    for (int n = 0; n < 2; ++n) {
                        const int c = bcol + wc * 64 + bj * 32 + n * 16 + fq * 4;
                        const f32x4 x = *(const f32x4*)(xi + c), gg = *(const f32x4*)(gp + c);
                        *(f32x4*)(xout + (size_t)row * DM + c) = x + gg * acc[ai][bj][m][n];
                    }
            }
    }
};

typedef f32x4 AccT1[2][1][4][2];
struct EpiResid1 {
    const float* xin_ctx; const float* xin_lat; float* xout; const float* mod; int goff;
    __device__ __forceinline__ void operator()(AccT1& acc, const Unit& u, int brow, int bcol, int wr, int wc, int fr, int fq) const {
        const int cbase = (u.pn >> 1) * 256 + wc * 64 + (u.pn & 1) * 32 + fq * 4;
#pragma unroll
        for (int ai = 0; ai < 2; ++ai)
#pragma unroll
            for (int m = 0; m < 4; ++m) {
                const int row = brow + ai * 128 + wr * 64 + m * 16 + fr;
                const float* xi = row < NCTX ? xin_ctx + (size_t)row * DM : xin_lat + (size_t)(row - NCTX) * DM;
                const float* gp = mod + condof(row) * 6144 + goff;
#pragma unroll
                for (int n = 0; n < 2; ++n) {
                    const int c = cbase + n * 16;
                    const f32x4 x = *(const f32x4*)(xi + c), gg = *(const f32x4*)(gp + c);
                    *(f32x4*)(xout + (size_t)row * DM + c) = x + gg * acc[ai][0][m][n];
                }
            }
    }
};

struct EpiUp {
    bf16_t* GV; int rbase;
    __device__ __forceinline__ void operator()(AccT& acc, const Unit& u, int brow, int bcol, int wr, int wc, int fr, int fq) const {
#pragma unroll
        for (int ai = 0; ai < 2; ++ai)
#pragma unroll
            for (int m = 0; m < 4; ++m) {
                const int row = brow + ai * 128 + wr * 64 + m * 16 + fr - rbase;
#pragma unroll
                for (int bj = 0; bj < 2; ++bj)
#pragma unroll
                    for (int n = 0; n < 2; ++n) {
                        const int c = bcol + wc * 64 + bj * 32 + n * 16 + fq * 4;
                        u32x2 w; w.x = pk2(acc[ai][bj][m][n][0], acc[ai][bj][m][n][1]); w.y = pk2(acc[ai][bj][m][n][2], acc[ai][bj][m][n][3]);
                        *(u32x2*)(GV + (size_t)row * 5632 + c) = w;
                    }
            }
    }
};

struct EpiResidAtomic {
    float* x; const float* mod; int goff;
    __device__ __forceinline__ void operator()(AccT& acc, const Unit& u, int brow, int bcol, int wr, int wc, int fr, int fq) const {
#pragma unroll
        for (int ai = 0; ai < 2; ++ai)
#pragma unroll
            for (int m = 0; m < 4; ++m) {
                const int row = brow + ai * 128 + wr * 64 + m * 16 + fr;
                const float* gp = mod + condof(row) * 6144 + goff;
#pragma unroll
                for (int bj = 0; bj < 2; ++bj)
#pragma unroll
                    for (int n = 0; n < 2; ++n) {
                        const int c = bcol + wc * 64 + bj * 32 + n * 16 + fq * 4;
                        const f32x4 gg = *(const f32x4*)(gp + c);
                        float* xp = x + (size_t)row * DM + c;
#pragma unroll
                        for (int j = 0; j < 4; ++j) unsafeAtomicAdd(xp + j, gg[j] * acc[ai][bj][m][n][j]);
                    }
            }
    }
};

struct EpiGlu {
    const bf16_t* YG; bf16_t* MIX; const float* bias;
    __device__ __forceinline__ void operator()(AccT& acc, const Unit& u, int brow, int bcol, int wr, int wc, int fr, int fq) const {
#pragma unroll
        for (int ai = 0; ai < 2; ++ai)
#pragma unroll
            for (int m = 0; m < 4; ++m) {
                const int row = brow + ai * 128 + wr * 64 + m * 16 + fr;
#pragma unroll
                for (int bj = 0; bj < 2; ++bj)
#pragma unroll
                    for (int n = 0; n < 2; ++n) {
                        const int c = bcol + wc * 64 + bj * 32 + n * 16 + fq * 4;
                        const f32x4 bb = *(const f32x4*)(bias + c);
                        const u32x2 yw = *(const u32x2*)(YG + (size_t)row * 512 + c);
                        const f32x4 z = acc[ai][bj][m][n] + bb;
                        const float y0 = bflo(yw.x) * sigmf(z[0]), y1 = bfhi(yw.x) * sigmf(z[1]), y2 = bflo(yw.y) * sigmf(z[2]), y3 = bfhi(yw.y) * sigmf(z[3]);
                        u32x2 w; w.x = pk2(y0, y1); w.y = pk2(y2, y3);
                        *(u32x2*)(MIX + (size_t)row * DM + 512 + c) = w;
                    }
            }
    }
};


__device__ __forceinline__ float dpp_ror1(float v) { return __int_as_float(__builtin_amdgcn_update_dpp(0, __float_as_int(v), 0x121, 0xF, 0xF, false)); }
__device__ __forceinline__ float dpp_ror15(float v) { return __int_as_float(__builtin_amdgcn_update_dpp(0, __float_as_int(v), 0x12F, 0xF, 0xF, false)); }
constexpr int LDS_EX = 131072 + 256;
struct EpiUpConv {
    bf16_t* ACT; const float* cw; const float* cb;
    __device__ __forceinline__ void operator()(AccT& acc, const Unit& u, int brow, int bcol, int wr, int wc, int fr, int fq) const {
        extern __shared__ __attribute__((aligned(16))) unsigned char smem[];
        float* EX = (float*)(smem + LDS_EX);
        const bool sp = u.sp != 0;
        const bool lat = !sp && u.pm >= 16;
        const bool first = lat && (((u.pm - 16) & 15) == 0);
#pragma unroll
        for (int ai = 0; ai < 2; ++ai) {
#pragma unroll
            for (int m = 0; m < 4; ++m) {
                const int rl = ai * 128 + wr * 64 + m * 16 + fr;
                if (sp ? ((rl & 63) >= 33) : (first && rl == 0)) { acc[ai][0][m][0] = (f32x4){0.f, 0.f, 0.f, 0.f}; acc[ai][0][m][1] = (f32x4){0.f, 0.f, 0.f, 0.f}; }
            }
            const int sidx = ai * 2 + wr;
            if (fr == 0) {
#pragma unroll
                for (int n = 0; n < 2; ++n) *(f32x4*)(EX + ((0 * 4 + sidx) * 4 + wc) * 32 + n * 16 + fq * 4) = acc[ai][0][0][n];
            }
            if (fr == 15) {
#pragma unroll
                for (int n = 0; n < 2; ++n) *(f32x4*)(EX + ((1 * 4 + sidx) * 4 + wc) * 32 + n * 16 + fq * 4) = acc[ai][0][3][n];
            }
        }
        __syncthreads();
        const int f0 = (bcol >> 1) + wc * 32 + fq * 4;
#pragma unroll
        for (int n = 0; n < 2; ++n) {
            const int f = f0 + n * 16;
            const f32x4 w0 = *(const f32x4*)(cw + f), w1 = *(const f32x4*)(cw + DFF + f), w2 = *(const f32x4*)(cw + 2 * DFF + f), bb = *(const f32x4*)(cb + f);
#pragma unroll
            for (int ai = 0; ai < 2; ++ai) {
                const int sidx = ai * 2 + wr;
                f32x4 exp_ = (f32x4){0.f, 0.f, 0.f, 0.f}, exn = (f32x4){0.f, 0.f, 0.f, 0.f};
                if (sidx > 0) exp_ = *(const f32x4*)(EX + ((1 * 4 + sidx - 1) * 4 + wc) * 32 + n * 16 + fq * 4);
                if (sidx < 3) exn = *(const f32x4*)(EX + ((0 * 4 + sidx + 1) * 4 + wc) * 32 + n * 16 + fq * 4);
#pragma unroll
                for (int m = 0; m < 4; ++m) {
                    const int rl = ai * 128 + wr * 64 + m * 16 + fr;
                    const f32x4 cur = acc[ai][0][m][n];
                    f32x4 pv, nx;
#pragma unroll
                    for (int j = 0; j < 4; ++j) {
                        const float pw = m > 0 ? dpp_ror1(acc[ai][0][m > 0 ? m - 1 : 0][n][j]) : exp_[j];
                        pv[j] = __int_as_float(__builtin_amdgcn_update_dpp(__float_as_int(pw), __float_as_int(cur[j]), 0x111, 0xF, 0xF, false));
                        const float nw = m < 3 ? dpp_ror15(acc[ai][0][m < 3 ? m + 1 : 3][n][j]) : exn[j];
                        nx[j] = __int_as_float(__builtin_amdgcn_update_dpp(__float_as_int(nw), __float_as_int(cur[j]), 0x101, 0xF, 0xF, false));
                    }
                    const f32x4 c = w0 * pv + w1 * cur + w2 * nx + bb;
                    const f32x4 vv = acc[ai][1][m][n];
                    u32x2 o; o.x = pk2(siluf(c[0]) * vv[0], siluf(c[1]) * vv[1]); o.y = pk2(siluf(c[2]) * vv[2], siluf(c[3]) * vv[3]);
                    const int jj = rl & 63;
                    const bool wr_ok = sp ? (jj >= 1 && jj < 33) : (!lat || (rl != 0 && rl != 255));
                    const int orow = sp ? brow + (rl >> 6) * 4096 + jj : brow + rl;
                    if (wr_ok) *(u32x2*)(ACT + (size_t)orow * DFF + f) = o;
                }
            }
        }
    }
};

#ifndef GSEL
#define GSEL -1
#endif
template <int ID, class Epi>
__device__ __forceinline__ void run_gemm(const bf16_t* A, int lda, const bf16_t* Bt, int K, int N, int row0, int nrows, const Epi& epi, int ksplit = 1) {
    if (!EN_GEMM) return;
    if (GSEL >= 0 && ID != GSEL) return;
    Gemm g{A, Bt, lda, K, K / ksplit};
    Order S{row0 / BM, nrows / BM, N / BM, (nrows / BM) * (N / BM), (int)gridDim.x, (int)blockIdx.x, 0, ksplit};
    gemm_phase<false>(g, S, epi);
}
template <class Epi>
__device__ __forceinline__ void run_gemm_n128(const bf16_t* A, int lda, const bf16_t* Bt, int K, int N, const Epi& epi) {
    if (!EN_GEMM) return;
    Gemm g{A, Bt, lda, K, K};
    Order S{0, NTOK / BM, N / HALF, (NTOK / BM) * (N / HALF), (int)gridDim.x, (int)blockIdx.x, 0, 1};
    gemm_phase_n128(g, S, epi);
}
template <class Epi>
__device__ __forceinline__ void run_gemm_up(const bf16_t* A, const bf16_t* Bt, const Epi& epi) {
    if (!EN_GEMM) return;
    Gemm g{A, Bt, DM, DM, DM};
    Order S{0, 81, 22, 81 * 22, (int)gridDim.x, (int)blockIdx.x, 1, 1};
    gemm_phase<true>(g, S, epi);
}

struct AttnUnit {
    const bf16_t* Q; int qs;
    const bf16_t *K1, *V1; int s1, n1;
    const bf16_t *K2, *V2; int s2, n2;
    bf16_t* O; int os;
    int kind, r0, rb0; const float* rpb;
    const float* gq; const float* gk; const unsigned* kmax; int kw;
};
__device__ __forceinline__ int swz8(int row) { return (((row >> 1) & 1) << 2) | (((row >> 2) & 1) << 1) | ((row >> 3) & 1); }
__device__ __forceinline__ s16x4 vtr(const unsigned char* p) { return __builtin_bit_cast(s16x4, __builtin_amdgcn_ds_read_tr16_b64_v4i16((LAS s16x4*)p)); }

__device__ __forceinline__ void attn_unit_old(const AttnUnit& u) {
    extern __shared__ __attribute__((aligned(16))) unsigned char smem[];
    const int tid = otid(), w = tid >> 6, lane = tid & 63, r32 = lane & 31, hh = lane >> 5;
    float* rpbs = (float*)(smem + 32768);
    __syncthreads();
    if (u.kind == 1) { for (int i = tid; i < 465; i += NTHREADS) rpbs[i] = u.rpb[i] * 1.4426950408889634f; }
    bf16x8 qf[4];
    {
        const bf16_t* qp = u.Q + (size_t)(32 * w + r32) * u.qs + 8 * hh;
#pragma unroll
        for (int ks = 0; ks < 4; ++ks) qf[ks] = *(const bf16x8*)(qp + 16 * ks);
    }
    f32x16 o0, o1;
#pragma unroll
    for (int i = 0; i < 16; ++i) { o0[i] = 0.f; o1[i] = 0.f; }
    float mrun = -1e30f, lsum = 0.f;
    const int nt = u.n1 + u.n2;
    const int srow = tid >> 3, sch = tid & 7;
    const int soff = srow * 128 + ((sch ^ swz8(srow)) << 4);
    u32x4 kreg, vreg;
    {
        const bf16_t* kp = u.n1 > 0 ? u.K1 : u.K2; const bf16_t* vp = u.n1 > 0 ? u.V1 : u.V2; const int st = u.n1 > 0 ? u.s1 : u.s2;
        kreg = *(const u32x4*)(kp + (size_t)srow * st + sch * 8); vreg = *(const u32x4*)(vp + (size_t)srow * st + sch * 8);
    }
    const float SC = 0.125f * 1.4426950408889634f;
    const int qrow = u.r0 + (w >> 1), qc = (w & 1) * 32 + r32;
    const int rs = min(max(qrow - 4, 0), 56), cs = min(max(qc - 8, 0), 48);
    for (int ti = 0; ti < nt; ++ti) {
        unsigned char* kb_ = smem + (ti & 1) * 16384;
        unsigned char* vb_ = kb_ + 8192;
        *(u32x4*)(kb_ + soff) = kreg; *(u32x4*)(vb_ + soff) = vreg;
        __syncthreads();
        if (ti + 1 < nt) {
            const int tn = ti + 1;
            const bf16_t* kp; const bf16_t* vp; int st;
            if (tn < u.n1) { kp = u.K1 + (size_t)tn * 64 * u.s1; vp = u.V1 + (size_t)tn * 64 * u.s1; st = u.s1; }
            else { kp = u.K2 + (size_t)(tn - u.n1) * 64 * u.s2; vp = u.V2 + (size_t)(tn - u.n1) * 64 * u.s2; st = u.s2; }
            kreg = *(const u32x4*)(kp + (size_t)srow * st + sch * 8); vreg = *(const u32x4*)(vp + (size_t)srow * st + sch * 8);
        }
        const bool local = (u.kind == 1) && (ti < u.n1);
        int dr = 0;
        if (local) { const int kr = u.rb0 + ti; if (kr < rs || kr >= rs + 8) continue; dr = kr - qrow + 7; }
        f32x16 st0, st1;
#pragma unroll
        for (int i = 0; i < 16; ++i) { st0[i] = 0.f; st1[i] = 0.f; }
#pragma unroll
        for (int ks = 0; ks < 4; ++ks) {
            const int ch = 2 * ks + hh;
            const int ra = r32, rb = 32 + r32;
            const bf16x8 ka = *(const bf16x8*)(kb_ + ra * 128 + ((ch ^ swz8(ra)) << 4));
            const bf16x8 kb2 = *(const bf16x8*)(kb_ + rb * 128 + ((ch ^ swz8(rb)) << 4));
            st0 = __builtin_amdgcn_mfma_f32_32x32x16_bf16(ka, qf[ks], st0, 0, 0, 0);
            st1 = __builtin_amdgcn_mfma_f32_32x32x16_bf16(kb2, qf[ks], st1, 0, 0, 0);
        }
        float tmax = -1e30f;
        if (local) {
            const float* rp = rpbs + dr * 31;
#pragma unroll
            for (int i = 0; i < 16; ++i) {
                const int kc0 = (i & 3) + 8 * (i >> 2) + 4 * hh, kc1 = kc0 + 32;
                const bool v0 = (kc0 >= cs) && (kc0 < cs + 16), v1 = (kc1 >= cs) && (kc1 < cs + 16);
                const float b0 = rp[v0 ? kc0 - qc + 15 : 0], b1 = rp[v1 ? kc1 - qc + 15 : 0];
                st0[i] = v0 ? st0[i] + b0 : -1e30f;
                st1[i] = v1 ? st1[i] + b1 : -1e30f;
            }
        }
#pragma unroll
        for (int i = 0; i < 16; ++i) tmax = fmaxf(tmax, fmaxf(st0[i], st1[i]));
        tmax = fmaxf(tmax, __shfl_xor(tmax, 32));
        const float mnew = fmaxf(mrun, tmax);
        const float alpha = __builtin_amdgcn_exp2f(mrun - mnew);
        mrun = mnew;
        float ps = 0.f;
#pragma unroll
        for (int i = 0; i < 16; ++i) { st0[i] = __builtin_amdgcn_exp2f(st0[i] - mnew); st1[i] = __builtin_amdgcn_exp2f(st1[i] - mnew); ps += st0[i] + st1[i]; }
        lsum = lsum * alpha + ps;
#pragma unroll
        for (int i = 0; i < 16; ++i) { o0[i] *= alpha; o1[i] *= alpha; }
#pragma unroll
        for (int kb = 0; kb < 2; ++kb)
#pragma unroll
            for (int s = 0; s < 2; ++s) {
                u32x4 pw;
                if (kb == 0) { pw.x = pk2(st0[8 * s + 0], st0[8 * s + 1]); pw.y = pk2(st0[8 * s + 2], st0[8 * s + 3]); pw.z = pk2(st0[8 * s + 4], st0[8 * s + 5]); pw.w = pk2(st0[8 * s + 6], st0[8 * s + 7]); }
                else { pw.x = pk2(st1[8 * s + 0], st1[8 * s + 1]); pw.y = pk2(st1[8 * s + 2], st1[8 * s + 3]); pw.z = pk2(st1[8 * s + 4], st1[8 * s + 5]); pw.w = pk2(st1[8 * s + 6], st1[8 * s + 7]); }
                const bf16x8 pf = __builtin_bit_cast(bf16x8, pw);
                const int kbase = kb * 32 + 16 * s + 4 * hh;
                const int q = (lane & 15) >> 2, p4 = lane & 3, gsel = (lane >> 4) & 1;
#pragma unroll
                for (int db = 0; db < 2; ++db) {
                    const int dcol = db * 32 + 16 * gsel + 4 * p4;
                    const int r1 = kbase + q, r2 = kbase + 8 + q;
                    const s16x4 a1 = vtr(vb_ + r1 * 128 + (((dcol >> 3) ^ swz8(r1)) << 4) + (dcol & 7) * 2);
                    const s16x4 a2 = vtr(vb_ + r2 * 128 + (((dcol >> 3) ^ swz8(r2)) << 4) + (dcol & 7) * 2);
                    bf16x8 vf; vf[0] = a1[0]; vf[1] = a1[1]; vf[2] = a1[2]; vf[3] = a1[3]; vf[4] = a2[0]; vf[5] = a2[1]; vf[6] = a2[2]; vf[7] = a2[3];
                    if (db == 0) o0 = __builtin_amdgcn_mfma_f32_32x32x16_bf16(vf, pf, o0, 0, 0, 0);
                    else o1 = __builtin_amdgcn_mfma_f32_32x32x16_bf16(vf, pf, o1, 0, 0, 0);
                }
            }
    }
    lsum += __shfl_xor(lsum, 32);
    const float inv = 1.0f / lsum;
    bf16_t* op = u.O + (size_t)(32 * w + r32) * u.os;
#pragma unroll
    for (int rg = 0; rg < 4; ++rg) {
        u32x2 w0, w1;
        w0.x = pk2(o0[4 * rg] * inv, o0[4 * rg + 1] * inv); w0.y = pk2(o0[4 * rg + 2] * inv, o0[4 * rg + 3] * inv);
        w1.x = pk2(o1[4 * rg] * inv, o1[4 * rg + 1] * inv); w1.y = pk2(o1[4 * rg + 2] * inv, o1[4 * rg + 3] * inv);
        *(u32x2*)(op + 8 * rg + 4 * hh) = w0;
        *(u32x2*)(op + 32 + 8 * rg + 4 * hh) = w1;
    }
}

template <bool NA>
__device__ __forceinline__ void attn_unit64(const AttnUnit& u) {
    extern __shared__ __attribute__((aligned(16))) unsigned char smem[];
    const int tid = otid(), w = tid >> 6, lane = tid & 63, r32 = lane & 31, hh = lane >> 5;
    float* rpbs = (float*)(smem + 32768);
    __syncthreads();
    if (NA) { for (int i = tid; i < 465; i += NTHREADS) rpbs[i] = u.rpb[i] * 1.4426950408889634f; }
    const int qrow = u.r0 + w;
    const int rs = min(max(qrow - 4, 0), 56);
    bf16x8 qf[2][4];
#pragma unroll
    for (int qb = 0; qb < 2; ++qb) {
        const bf16_t* qp = u.Q + (size_t)(64 * w + 32 * qb + r32) * u.qs + 8 * hh;
#pragma unroll
        for (int ks = 0; ks < 4; ++ks) qf[qb][ks] = *(const bf16x8*)(qp + 16 * ks);
    }
    f32x16 o[2][2];
#pragma unroll
    for (int qb = 0; qb < 2; ++qb)
#pragma unroll
        for (int db = 0; db < 2; ++db)
#pragma unroll
            for (int i = 0; i < 16; ++i) o[qb][db][i] = 0.f;
    float lsum[2] = {0.f, 0.f};
    float nmS;
    {
        float g1 = fabsf(u.gq[lane]), g2 = fabsf(u.gk[lane]);
#pragma unroll
        for (int o_ = 32; o_ >= 1; o_ >>= 1) { g1 = fmaxf(g1, __shfl_xor(g1, o_)); g2 = fmaxf(g2, __shfl_xor(g2, o_)); }
        const float kc = sqrtf(__uint_as_float(u.kmax[u.kw]));
        const float mk = fmaxf(8.0f * g2, kc) * 1.01f, mq = 8.0f * g1 * 1.01f;
        nmS = -(QSC * mq * mk + (NA ? __uint_as_float(u.kmax[2]) * 1.4426950408889634f : 0.f));
    }
    if (-nmS > 100.0f) {
        AttnUnit v = u; attn_unit_old(v);
        v.Q += (size_t)256 * u.qs; v.O += (size_t)256 * u.os; v.r0 += 4; attn_unit_old(v);
        return;
    }
    const int nt = u.n1 + u.n2;
    const int srow = tid >> 3, sch = (tid & 7) ^ swz8(tid >> 3);
    LAS unsigned char* ldsb = (LAS unsigned char*)smem;
#define A64_DMA(tn, bufoff) do { const bf16_t* kp_; const bf16_t* vp_; int st_; \
        if ((tn) < u.n1) { kp_ = u.K1 + (size_t)(tn) * 64 * u.s1; vp_ = u.V1 + (size_t)(tn) * 64 * u.s1; st_ = u.s1; } \
        else { kp_ = u.K2 + (size_t)((tn) - u.n1) * 64 * u.s2; vp_ = u.V2 + (size_t)((tn) - u.n1) * 64 * u.s2; st_ = u.s2; } \
        __builtin_amdgcn_global_load_lds((const unsigned*)(kp_ + (size_t)srow * st_ + sch * 8), (LAS unsigned*)(ldsb + (bufoff) + tid * 16), 16, 0, 0); \
        __builtin_amdgcn_global_load_lds((const unsigned*)(vp_ + (size_t)srow * st_ + sch * 8), (LAS unsigned*)(ldsb + (bufoff) + 8192 + tid * 16), 16, 0, 0); } while (0)
    A64_DMA(0, 0);
    const float SC = 0.125f * 1.4426950408889634f;
    const int q4 = (lane & 15) >> 2, p4 = lane & 3, gsel = (lane >> 4) & 1;
    if (__builtin_amdgcn_readfirstlane(tid) >= 256) __builtin_amdgcn_s_setprio(1);
    for (int ti = 0; ti < nt; ++ti) {
        unsigned char* kb_ = smem + (ti & 1) * 16384;
        unsigned char* vb_ = kb_ + 8192;
        asm volatile("s_waitcnt vmcnt(0)" ::: "memory");
        __syncthreads();
        if (ti + 1 < nt) A64_DMA(ti + 1, ((ti + 1) & 1) * 16384);
        const bool local = NA && (ti < u.n1);
        if (local) { const int kr = u.rb0 + ti; if (kr < rs || kr >= rs + 8) continue; }
        f32x16 st_[2][2];
#pragma unroll
        for (int qb = 0; qb < 2; ++qb)
#pragma unroll
            for (int kb = 0; kb < 2; ++kb)
#pragma unroll
                for (int i = 0; i < 16; ++i) st_[qb][kb][i] = 0.f;
#pragma unroll
        for (int ks = 0; ks < 4; ++ks) {
            const int ch = 2 * ks + hh;
            const int ra = r32, rb = 32 + r32;
            const bf16x8 ka = *(const bf16x8*)(kb_ + ra * 128 + ((ch ^ swz8(ra)) << 4));
            const bf16x8 kb2 = *(const bf16x8*)(kb_ + rb * 128 + ((ch ^ swz8(rb)) << 4));
#pragma unroll
            for (int qb = 0; qb < 2; ++qb) {
                st_[qb][0] = __builtin_amdgcn_mfma_f32_32x32x16_bf16(ka, qf[qb][ks], st_[qb][0], 0, 0, 0);
                st_[qb][1] = __builtin_amdgcn_mfma_f32_32x32x16_bf16(kb2, qf[qb][ks], st_[qb][1], 0, 0, 0);
            }
        }
        bf16x8 pfs[2][4];
#pragma unroll
        for (int qb = 0; qb < 2; ++qb) {
            if (local) {
                const float* rp = rpbs + (u.rb0 + ti - qrow + 7) * 31;
                const int qc = 32 * qb + r32, cs = min(max(qc - 8, 0), 48);
#pragma unroll
                for (int i = 0; i < 16; ++i) {
                    const int kc0 = (i & 3) + 8 * (i >> 2) + 4 * hh, kc1 = kc0 + 32;
                    const bool v0 = (kc0 >= cs) && (kc0 < cs + 16), v1 = (kc1 >= cs) && (kc1 < cs + 16);
                    const float b0 = rp[v0 ? kc0 - qc + 15 : 0], b1 = rp[v1 ? kc1 - qc + 15 : 0];
                    st_[qb][0][i] = v0 ? st_[qb][0][i] + b0 : -1e30f;
                    st_[qb][1][i] = v1 ? st_[qb][1][i] + b1 : -1e30f;
                }
            }
            float ps = 0.f;
#pragma unroll
            for (int i = 0; i < 16; ++i) {
                st_[qb][0][i] = __builtin_amdgcn_exp2f(st_[qb][0][i]);
                st_[qb][1][i] = __builtin_amdgcn_exp2f(st_[qb][1][i]);
                ps += st_[qb][0][i] + st_[qb][1][i];
            }
            lsum[qb] += ps;
#pragma unroll
            for (int kb = 0; kb < 2; ++kb)
#pragma unroll
                for (int s2 = 0; s2 < 2; ++s2) {
                    u32x4 pw;
                    pw.x = pk2(st_[qb][kb][8 * s2 + 0], st_[qb][kb][8 * s2 + 1]); pw.y = pk2(st_[qb][kb][8 * s2 + 2], st_[qb][kb][8 * s2 + 3]);
                    pw.z = pk2(st_[qb][kb][8 * s2 + 4], st_[qb][kb][8 * s2 + 5]); pw.w = pk2(st_[qb][kb][8 * s2 + 6], st_[qb][kb][8 * s2 + 7]);
                    pfs[qb][kb * 2 + s2] = __builtin_bit_cast(bf16x8, pw);
                }
        }
#pragma unroll
        for (int kb = 0; kb < 2; ++kb)
#pragma unroll
            for (int s2 = 0; s2 < 2; ++s2) {
                const int kbase = kb * 32 + 16 * s2 + 4 * hh;
#pragma unroll
                for (int db = 0; db < 2; ++db) {
                    const int dcol = db * 32 + 16 * gsel + 4 * p4;
                    const int r1 = kbase + q4, r2 = kbase + 8 + q4;
                    const s16x4 a1 = vtr(vb_ + r1 * 128 + (((dcol >> 3) ^ swz8(r1)) << 4) + (dcol & 7) * 2);
                    const s16x4 a2 = vtr(vb_ + r2 * 128 + (((dcol >> 3) ^ swz8(r2)) << 4) + (dcol & 7) * 2);
                    bf16x8 vf; vf[0] = a1[0]; vf[1] = a1[1]; vf[2] = a1[2]; vf[3] = a1[3]; vf[4] = a2[0]; vf[5] = a2[1]; vf[6] = a2[2]; vf[7] = a2[3];
#pragma unroll
                    for (int qb = 0; qb < 2; ++qb) o[qb][db] = __builtin_amdgcn_mfma_f32_32x32x16_bf16(vf, pfs[qb][kb * 2 + s2], o[qb][db], 0, 0, 0);
                }
            }
    }
#undef A64_DMA
    __builtin_amdgcn_s_setprio(0);
#pragma unroll
    for (int qb = 0; qb < 2; ++qb) {
        float l = lsum[qb]; l += __shfl_xor(l, 32);
        const float inv = 1.0f / l;
        bf16_t* op = u.O + (size_t)(64 * w + 32 * qb + r32) * u.os;
#pragma unroll
        for (int rg = 0; rg < 4; ++rg) {
            u32x2 w0, w1;
            w0.x = pk2(o[qb][0][4 * rg] * inv, o[qb][0][4 * rg + 1] * inv); w0.y = pk2(o[qb][0][4 * rg + 2] * inv, o[qb][0][4 * rg + 3] * inv);
            w1.x = pk2(o[qb][1][4 * rg] * inv, o[qb][1][4 * rg + 1] * inv); w1.y = pk2(o[qb][1][4 * rg + 2] * inv, o[qb][1][4 * rg + 3] * inv);
            *(u32x2*)(op + 8 * rg + 4 * hh) = w0;
            *(u32x2*)(op + 32 + 8 * rg + 4 * hh) = w1;
        }
    }
}

template <bool PASS2>
__device__ __forceinline__ void ssm_task(const Params& P, int task) {
    extern __shared__ __attribute__((aligned(16))) unsigned char smem[];
    unsigned char* ws = P.ws;
    const int tid = otid(), w = tid >> 6, lane = tid & 63, n = lane & 31, hh = lane >> 5;
    const int pj = task >> 2, g = (task & 3) * 8 + w;
    const bf16_t* U = (const bf16_t*)(ws + WS_U);
    const float* ENDr = (const float*)(ws + WS_END);
    float* ENDw = (float*)(ws + WS_END);
    unsigned char* himg = smem + w * 8192;
    const int c_l = 2 * pj + hh;
    int kidx_l, nch, seqb; bool ctx;
    if (c_l < 64) { ctx = true; kidx_l = c_l & 3; nch = 4; seqb = c_l >> 2; }
    else { ctx = false; kidx_l = (c_l - 64) & 63; nch = 64; seqb = (c_l - 64) >> 6; }
    const int cs0 = c_l - kidx_l;
    const int kidx0 = kidx_l - hh;
    f32x4 yacc[2][4];
#pragma unroll
    for (int a = 0; a < 2; ++a)
#pragma unroll
        for (int b = 0; b < 4; ++b) yacc[a][b] = (f32x4){0.f, 0.f, 0.f, 0.f};

#pragma unroll 1
    for (int dir = 0; dir < 2; ++dir) {
        const int dg = dir * 32 + g;
        bf16x8 bmf[2][2];
#pragma unroll
        for (int comp = 0; comp < 2; ++comp)
#pragma unroll
            for (int sh = 0; sh < 2; ++sh) bmf[comp][sh] = *(const bf16x8*)((const bf16_t*)(ws + WS_BM) + ((size_t)((dg * 2 + comp) * 64 + sh * 32 + n)) * 16 + 8 * hh);
        bf16x8 cmf[4];
        if (PASS2) {
#pragma unroll
            for (int ks = 0; ks < 4; ++ks) cmf[ks] = *(const bf16x8*)((const bf16_t*)(ws + WS_CM) + ((size_t)(dg * 16 + (lane & 15))) * 128 + 32 * ks + 8 * (lane >> 4));
        }
        float ar[2], ai[2], hr[2], hi[2];
#pragma unroll
        for (int sh = 0; sh < 2; ++sh) {
            const f32x2 a = *(const f32x2*)((const float*)(ws + WS_SSA) + ((size_t)(dg * 64 + sh * 32 + n)) * 2);
            ar[sh] = a.x; ai[sh] = a.y; hr[sh] = 0.f; hi[sh] = 0.f;
        }
        if (PASS2) {
            const float* e = ENDr + ((size_t)((c_l * 2 + dir) * 32 + g)) * 128;
#pragma unroll
            for (int sh = 0; sh < 2; ++sh) { hr[sh] = e[sh * 32 + n]; hi[sh] = e[64 + sh * 32 + n]; }
        }
#pragma unroll 1
        for (int bb = 0; bb < 4; ++bb) {
            const int blk = dir == 0 ? bb : 3 - bb;
            const int m_ = lane & 31;
            const int arow = 64 * (2 * pj + ((m_ >> 2) & 1)) + 16 * blk + (m_ & 3) + 4 * (m_ >> 3);
            const bf16x8 af = *(const bf16x8*)(U + (size_t)arow * 512 + 16 * g + 8 * hh);
            f32x16 bu[2][2];
#pragma unroll
            for (int comp = 0; comp < 2; ++comp)
#pragma unroll
                for (int sh = 0; sh < 2; ++sh) {
                    f32x16 z;
#pragma unroll
                    for (int i = 0; i < 16; ++i) z[i] = 0.f;
                    bu[comp][sh] = __builtin_amdgcn_mfma_f32_32x32x16_bf16(af, bmf[comp][sh], z, 0, 0, 0);
                }
#pragma unroll
            for (int sh = 0; sh < 2; ++sh) {
                float cr = hr[sh], ci = hi[sh];
                const float a_r = ar[sh], a_i = ai[sh];
#pragma unroll
                for (int ii = 0; ii < 16; ++ii) {
                    const int i = dir == 0 ? ii : 15 - ii;
                    const float nr = a_r * cr - a_i * ci + bu[0][sh][i];
                    const float ni = a_r * ci + a_i * cr + bu[1][sh][i];
                    cr = nr; ci = ni; bu[0][sh][i] = cr; bu[1][sh][i] = ci;
                }
                hr[sh] = cr; hi[sh] = ci;
            }
            if (PASS2) {
                asm volatile("s_waitcnt lgkmcnt(0)" ::: "memory");
#pragma unroll
                for (int comp = 0; comp < 2; ++comp)
#pragma unroll
                    for (int sh = 0; sh < 2; ++sh) {
                        u32x4 w0, w1;
                        w0.x = pk2(bu[comp][sh][0], bu[comp][sh][1]); w0.y = pk2(bu[comp][sh][2], bu[comp][sh][3]); w0.z = pk2(bu[comp][sh][4], bu[comp][sh][5]); w0.w = pk2(bu[comp][sh][6], bu[comp][sh][7]);
                        w1.x = pk2(bu[comp][sh][8], bu[comp][sh][9]); w1.y = pk2(bu[comp][sh][10], bu[comp][sh][11]); w1.z = pk2(bu[comp][sh][12], bu[comp][sh][13]); w1.w = pk2(bu[comp][sh][14], bu[comp][sh][15]);
                        unsigned char* hp = himg + (comp * 64 + sh * 32 + n) * 64 + hh * 32;
                        *(u32x4*)hp = w0; *(u32x4*)(hp + 16) = w1;
                    }
                asm volatile("s_waitcnt lgkmcnt(0)" ::: "memory");
                const int gq = lane >> 4, li = lane & 15, q = li >> 2, p4 = li & 3;
#pragma unroll
                for (int tt = 0; tt < 2; ++tt)
#pragma unroll
                    for (int ks = 0; ks < 4; ++ks) {
                        const unsigned char* hp = himg + (32 * ks + 8 * gq + q) * 64 + (16 * tt + 4 * p4) * 2;
                        const s16x4 a1 = vtr(hp), a2 = vtr(hp + 4 * 64);
                        bf16x8 hf; hf[0] = a1[0]; hf[1] = a1[1]; hf[2] = a1[2]; hf[3] = a1[3]; hf[4] = a2[0]; hf[5] = a2[1]; hf[6] = a2[2]; hf[7] = a2[3];
                        yacc[tt][blk] = __builtin_amdgcn_mfma_f32_16x16x32_bf16(cmf[ks], hf, yacc[tt][blk], 0, 0, 0);
                    }
            }
        }
        if (!PASS2) {
            float* e = ENDw + ((size_t)((c_l * 2 + dir) * 32 + g)) * 128;
#pragma unroll
            for (int sh = 0; sh < 2; ++sh) { e[sh * 32 + n] = hr[sh]; e[64 + sh * 32 + n] = hi[sh]; }
        } else if (ctx && ((dir == 0 && kidx_l == 3) || (dir == 1 && kidx_l == 0))) {
            const size_t si = ((size_t)((seqb * 2 + dir) * 32 + g)) * 64;
#pragma unroll
            for (int sh = 0; sh < 2; ++sh) { P.out[O_SRE + si + sh * 32 + n] = hr[sh]; P.out[O_SIM + si + sh * 32 + n] = hi[sh]; }
        }
    }
    if (PASS2) {
        bf16_t* YG = (bf16_t*)(ws + WS_YG);
        const int c4 = 4 * (lane >> 4);
        const f32x4 dd = *(const f32x4*)(P.in[30] + g * 16 + c4);
#pragma unroll
        for (int tt = 0; tt < 2; ++tt)
#pragma unroll
            for (int blk = 0; blk < 4; ++blk) {
                const int tok = 64 * (2 * pj + tt) + 16 * blk + (lane & 15);
                const u32x2 uw = *(const u32x2*)(U + (size_t)tok * 512 + 16 * g + c4);
                const float y0 = gelu_tanh(yacc[tt][blk][0] + dd[0] * bflo(uw.x)), y1 = gelu_tanh(yacc[tt][blk][1] + dd[1] * bfhi(uw.x));
                const float y2 = gelu_tanh(yacc[tt][blk][2] + dd[2] * bflo(uw.y)), y3 = gelu_tanh(yacc[tt][blk][3] + dd[3] * bfhi(uw.y));
                u32x2 o; o.x = pk2(y0, y1); o.y = pk2(y2, y3);
                *(u32x2*)(YG + (size_t)tok * 512 + 16 * g + c4) = o;
            }
    }
}

__device__ __forceinline__ void carry_phase(const Params& P) {
    unsigned char* ws = P.ws;
    float* END = (float*)(ws + WS_END);
    const int x = blockIdx.x * NTHREADS + otid();
    if (x >= 16384 + 65536) return;
    int seq, dir, g, p, nch, cs0; bool lat;
    if (x < 16384) { lat = true; seq = x >> 12; dir = (x >> 11) & 1; g = (x >> 6) & 31; p = x & 63; nch = 64; cs0 = 64 + seq * 64; }
    else { const int y = x - 16384; lat = false; seq = y >> 12; dir = (y >> 11) & 1; g = (y >> 6) & 31; p = y & 63; nch = 4; cs0 = seq * 4; }
    const int dg = dir * 32 + g;
    const f32x2 a64 = *(const f32x2*)((const float*)(ws + WS_SSA64) + ((size_t)(dg * 64 + p)) * 2);
    float cr = 0.f, ci = 0.f;
    if (lat) { const size_t si = ((size_t)((seq * 2 + dir) * 32 + g)) * 64 + p; cr = P.in[4][si]; ci = P.in[5][si]; }
    for (int k0 = 0; k0 < nch; k0 += 32) {
        float er[32], ei[32]; float* ep[32];
#pragma unroll
        for (int q = 0; q < 32; ++q) {
            const int k = min(k0 + q, nch - 1), ck = dir == 0 ? cs0 + k : cs0 + nch - 1 - k;
            ep[q] = END + ((size_t)((ck * 2 + dir) * 32 + g)) * 128 + p;
            er[q] = ep[q][0]; ei[q] = ep[q][64];
        }
#pragma unroll
        for (int q = 0; q < 32; ++q) {
            if (k0 + q < nch) {
                ep[q][0] = cr; ep[q][64] = ci;
                const float nr = a64.x * cr - a64.y * ci + er[q], ni = a64.x * ci + a64.y * cr + ei[q];
                cr = nr; ci = ni;
            }
        }
    }
}

struct WDesc { const float* src; bf16_t* dst; int K, N, tiles; };

template <bool UPPERM>
__device__ __forceinline__ void prep_wtile(const float* W, bf16_t* Wt, int K, int N, int tile) {
    extern __shared__ __attribute__((aligned(16))) unsigned char smem[];
    float* T = (float*)smem;
    const int nN = N / 256, tk = tile / nN, tn = tile % nN, k0 = tk * 64, n0 = tn * 256, tid = otid();
    __syncthreads();
    f32x4 v[8];
#pragma unroll
    for (int i = 0; i < 8; ++i) { const int idx = tid + 512 * i, k = idx >> 6, n4 = idx & 63; v[i] = *(const f32x4*)(W + (size_t)(k0 + k) * N + n0 + n4 * 4); }
#pragma unroll
    for (int i = 0; i < 8; ++i) { const int idx = tid + 512 * i, k = idx >> 6, n4 = idx & 63; float* t = T + k * 257 + n4 * 4; t[0] = v[i][0]; t[1] = v[i][1]; t[2] = v[i][2]; t[3] = v[i][3]; }
    __syncthreads();
#pragma unroll
    for (int i = 0; i < 4; ++i) {
        const int cidx = tid + 512 * i, nn = cidx >> 3, kc = cidx & 7;
        const int c = n0 + nn;
        int pos;
        if (UPPERM) { const int bjj = c >= DFF ? 1 : 0, f = c - bjj * DFF; pos = (f >> 7) * 256 + bjj * 128 + (f & 127); }
        else pos = (c & ~255) | (((c >> 5) & 1) << 7) | (((c >> 6) & 3) << 5) | (c & 31);
        const float* t = T + (kc * 8) * 257 + nn;
        u32x4 o;
        o.x = pk2(t[0], t[257]); o.y = pk2(t[2 * 257], t[3 * 257]); o.z = pk2(t[4 * 257], t[5 * 257]); o.w = pk2(t[6 * 257], t[7 * 257]);
        *(u32x4*)(Wt + (size_t)pos * K + k0 + kc * 8) = o;
    }
}

__device__ __forceinline__ void prep_mod(const Params& P, int task) {
    extern __shared__ __attribute__((aligned(16))) unsigned char smem[];
    float* S = (float*)smem;
    float* PS = S + 5 * 1024;
    const int l = task / 96, cb = task % 96, tid = otid();
    __syncthreads();
    for (int i = tid; i < 5 * 1024; i += NTHREADS) {
        const int j = i >> 10, k = i & 1023;
        const float v = j == 0 ? P.in[9][k] : P.in[8][(j - 1) * 1024 + k];
        S[i] = siluf(v);
    }
    __syncthreads();
    const int ks = tid >> 6, col = tid & 63;
    const float* W = P.in[12] + (size_t)l * 1024 * 6144 + cb * 64 + col;
    float a0 = 0, a1 = 0, a2 = 0, a3 = 0, a4 = 0;
    for (int k0 = ks * 128; k0 < ks * 128 + 128; k0 += 32) {
        float wv[32];
#pragma unroll
        for (int i = 0; i < 32; ++i) wv[i] = W[(size_t)(k0 + i) * 6144];
#pragma unroll
        for (int i = 0; i < 32; ++i) { const int k = k0 + i; a0 += S[k] * wv[i]; a1 += S[1024 + k] * wv[i]; a2 += S[2048 + k] * wv[i]; a3 += S[3072 + k] * wv[i]; a4 += S[4096 + k] * wv[i]; }
    }
    PS[(ks * 5 + 0) * 64 + col] = a0; PS[(ks * 5 + 1) * 64 + col] = a1; PS[(ks * 5 + 2) * 64 + col] = a2; PS[(ks * 5 + 3) * 64 + col] = a3; PS[(ks * 5 + 4) * 64 + col] = a4;
    __syncthreads();
    if (tid < 320) {
        const int j = tid >> 6, c = tid & 63;
        float s = P.in[13][l * 6144 + cb * 64 + c];
#pragma unroll
        for (int q = 0; q < 8; ++q) s += PS[(q * 5 + j) * 64 + c];
        ((float*)(P.ws + WS_MOD))[(l * 5 + j) * 6144 + cb * 64 + c] = s;
    }
}

__device__ __forceinline__ void prep_zoh(const Params& P, int task) {
    const int dg = task, tid = otid();
    unsigned char* ws = P.ws;
    if (tid < 64) {
        const int p = tid;
        const float are = P.in[23][dg * 64 + p], aim = P.in[24][dg * 64 + p];
        const float dt = expf(P.in[25][dg]);
        const float mag = expf(are * dt);
        float sn, cs; sincosf(aim * dt, &sn, &cs);
        const float abr = mag * cs, abi = mag * sn;
        const float den = are * are + aim * aim, nr = abr - 1.0f, ni = abi;
        const float kr = (nr * are + ni * aim) / den, ki = (ni * are - nr * aim) / den;
        float* sa = (float*)(ws + WS_SSA) + (size_t)(dg * 64 + p) * 2; sa[0] = abr; sa[1] = abi;
        float pr = abr, pi = abi;
#pragma unroll
        for (int i = 0; i < 6; ++i) { const float tr = pr * pr - pi * pi, ti = 2.0f * pr * pi; pr = tr; pi = ti; }
        float* s64 = (float*)(ws + WS_SSA64) + (size_t)(dg * 64 + p) * 2; s64[0] = pr; s64[1] = pi;
        bf16_t* bm = (bf16_t*)(ws + WS_BM);
        for (int c = 0; c < 16; ++c) {
            const float bre = P.in[26][(size_t)(dg * 64 + p) * 16 + c], bim = P.in[27][(size_t)(dg * 64 + p) * 16 + c];
            const float bbr = kr * bre - ki * bim, bbi = kr * bim + ki * bre;
            bm[((size_t)((dg * 2 + 0) * 64 + p)) * 16 + c] = (bf16_t)(pk2(bbr, 0.f) & 0xffff);
            bm[((size_t)((dg * 2 + 1) * 64 + p)) * 16 + c] = (bf16_t)(pk2(bbi, 0.f) & 0xffff);
        }
    }
    bf16_t* cm = (bf16_t*)(ws + WS_CM);
    for (int i = tid; i < 2048; i += NTHREADS) {
        const int c = i >> 7, pp = i & 127;
        const float v = pp < 64 ? P.in[28][(size_t)(dg * 16 + c) * 64 + pp] : -P.in[29][(size_t)(dg * 16 + c) * 64 + (pp - 64)];
        cm[(size_t)(dg * 16 + c) * 128 + pp] = (bf16_t)(pk2(v, 0.f) & 0xffff);
    }
}

__device__ __forceinline__ void prep_rope(const Params& P) {
    float* rp = (float*)(P.ws + WS_ROPE);
    for (int idx = otid(); idx < 1024; idx += NTHREADS) {
        const int pos = idx >> 4, i = idx & 15;
        const float f = powf(10000.0f, -(float)i / 16.0f);
        float sn, cs; sincosf((float)pos * f, &sn, &cs);
        rp[idx * 2] = cs; rp[idx * 2 + 1] = sn;
    }
    float mx = 0.f;
    for (int i = otid(); i < 8 * 465; i += NTHREADS) mx = fmaxf(mx, fabsf(P.in[22][i]));
    atomicMax((unsigned*)(P.ws + WS_KMAX) + 2, __float_as_uint(mx));
}

__device__ __forceinline__ void prep_cache(const Params& P, int task) {
    const float* src; bf16_t* dst; int t = task;
    if (t < 128) { src = P.in[2]; dst = (bf16_t*)(P.ws + WS_NAK); }
    else if (t < 256) { src = P.in[3]; dst = (bf16_t*)(P.ws + WS_NAV); t -= 128; }
    else if (t < 320) { src = P.in[6]; dst = (bf16_t*)(P.ws + WS_GQK); t -= 256; }
    else { src = P.in[7]; dst = (bf16_t*)(P.ws + WS_GQV); t -= 320; }
    const size_t e = (size_t)t * 4096 + otid() * 8;
    const f32x4 a = *(const f32x4*)(src + e), b = *(const f32x4*)(src + e + 4);
    u32x4 o; o.x = pk2(a[0], a[1]); o.y = pk2(a[2], a[3]); o.z = pk2(b[0], b[1]); o.w = pk2(b[2], b[3]);
    *(u32x4*)(dst + e) = o;
    if (task < 128 || (task >= 256 && task < 320)) {
        float ss = (a[0] * a[0] + a[1] * a[1]) + (a[2] * a[2] + a[3] * a[3]) + (b[0] * b[0] + b[1] * b[1]) + (b[2] * b[2] + b[3] * b[3]);
        ss += __shfl_xor(ss, 1); ss += __shfl_xor(ss, 2); ss += __shfl_xor(ss, 4);
        if ((threadIdx.x & 7) == 0) atomicMax((unsigned*)(P.ws + WS_KMAX) + (task < 128 ? 0 : 1), __float_as_uint(ss));
    }
}

__device__ __forceinline__ void norm_phase(const Params& P, int l, int which, const float* xc, const float* xl) {
    const float* gam = P.in[which == 0 ? 10 : 11] + l * DM;
    const float* mod = (const float*)(P.ws + WS_MOD) + (size_t)l * 5 * 6144;
    const int shoff = which == 0 ? 0 : 3072, scoff = shoff + 1024;
    bf16_t* H = (bf16_t*)(P.ws + WS_H);
    const int tid_ = otid(); const int lane = tid_ & 63, wv = tid_ >> 6;
    for (int row = blockIdx.x * 8 + wv; row < NTOK; row += gridDim.x * 8) {
        const float* x = row < NCTX ? xc + (size_t)row * DM : xl + (size_t)(row - NCTX) * DM;
        const float* mc = mod + condof(row) * 6144;
        f32x4 v[4]; float ss = 0.f;
#pragma unroll
        for (int i = 0; i < 4; ++i) { v[i] = *(const f32x4*)(x + lane * 4 + 256 * i); ss += v[i][0] * v[i][0] + v[i][1] * v[i][1] + v[i][2] * v[i][2] + v[i][3] * v[i][3]; }
        ss = wave_sum(ss);
        const float rstd = rsqrtf(ss * (1.0f / 1024.0f) + EPSN);
#pragma unroll
        for (int i = 0; i < 4; ++i) {
            const int c = lane * 4 + 256 * i;
            const f32x4 gg = *(const f32x4*)(gam + c), sc = *(const f32x4*)(mc + scoff + c), sh = *(const f32x4*)(mc + shoff + c);
            const f32x4 h = v[i] * rstd * gg * (sc + 1.0f) + sh;
            u32x2 o; o.x = pk2(h[0], h[1]); o.y = pk2(h[2], h[3]);
            *(u32x2*)(H + (size_t)row * DM + c) = o;
        }
    }
}

__device__ __forceinline__ void conv_phase(const Params& P, int l, int row0, int nrows) {
    bf16_t* GV = (bf16_t*)(P.ws + WS_GV);
    const float* cw = P.in[15] + (size_t)l * 3 * DFF;
    const float* cb = P.in[16] + (size_t)l * DFF;
    const long nitem = (long)nrows * 352;
    for (long it = (long)blockIdx.x * NTHREADS + otid(); it < nitem; it += (long)gridDim.x * NTHREADS) {
        const int r = (int)(it / 352), f = (int)(it % 352) * 8;
        const int row = row0 + r;
        int t, L;
        if (row < NCTX) { t = row & 255; L = 256; } else { t = (row - NCTX) & 4095; L = 4096; }
        bf16_t* gp = GV + (size_t)r * 5632 + f;
        const u32x4 g1 = *(const u32x4*)gp;
        u32x4 g0 = (u32x4){0, 0, 0, 0}, g2 = (u32x4){0, 0, 0, 0};
        if (t > 0) g0 = *(const u32x4*)(gp - 5632);
        if (t < L - 1) g2 = *(const u32x4*)(gp + 5632);
        const u32x4 vv = *(const u32x4*)(gp + DFF);
        u32x4 o;
#pragma unroll
        for (int q = 0; q < 4; ++q) {
            const int fa = f + 2 * q, fb = fa + 1;
            const float ca = cw[fa] * bflo(g0[q]) + cw[DFF + fa] * bflo(g1[q]) + cw[2 * DFF + fa] * bflo(g2[q]) + cb[fa];
            const float cbv = cw[fb] * bfhi(g0[q]) + cw[DFF + fb] * bfhi(g1[q]) + cw[2 * DFF + fb] * bfhi(g2[q]) + cb[fb];
            o[q] = pk2(siluf(ca) * bflo(vv[q]), siluf(cbv) * bfhi(vv[q]));
        }
        *(u32x4*)(gp + DFF) = o;
    }
}

#define XB_TMO      128
#define XB_XCNT(j)  (256  + 64 * (j))
#define XB_XSUB(j)  (1280 + 64 * (j))
#define XB_XGEN(j)  (2304 + 64 * (j))
#define XB_TOP      3328
#define XB_TOPGEN   3392
#define XCD_BAR_WORDS 3456
#define XB_SPIN_CAP (1u << 18)
__device__ __forceinline__ unsigned xb_ld(unsigned* p)              { return __hip_atomic_load(p, __ATOMIC_RELAXED, __HIP_MEMORY_SCOPE_AGENT); }
__device__ __forceinline__ unsigned xb_add(unsigned* p, unsigned v) { return __hip_atomic_fetch_add(p, v, __ATOMIC_RELAXED, __HIP_MEMORY_SCOPE_AGENT); }
__device__ __forceinline__ unsigned xb_xcc_id() { return (unsigned)__builtin_amdgcn_s_getreg((3 << 11) | 20) & 0xFu; }
#define XB_SPIN(cond, bar) do { unsigned _sp = 0; while (cond) { __builtin_amdgcn_s_sleep(1); \
    if ((++_sp & 255u) == 0u) { if (xb_ld(&(bar)[XB_TMO])) break; if (_sp > XB_SPIN_CAP) { atomicAdd(&(bar)[XB_TMO], 1u); break; } } } } while (0)
struct XcdBarrier { unsigned* bar; unsigned x; volatile LAS unsigned* st; };
__device__ __forceinline__ XcdBarrier xcd_barrier_post(unsigned* bar, volatile LAS unsigned* st) {
    XcdBarrier b; b.bar = bar; b.x = xb_xcc_id(); b.st = st;
    if (threadIdx.x == 0) (void)xb_add(&bar[XB_XCNT(b.x)], 1u);
    return b;
}
__device__ __forceinline__ void xcd_barrier_complete(unsigned* bar, unsigned x, unsigned& nloc, unsigned& nx) {
    const unsigned G = gridDim.x * gridDim.y * gridDim.z;
    unsigned sum, cnt, mine, sp = 0u;
    for (;;) {
        sum = 0u; cnt = 0u; mine = 0u;
#pragma unroll
        for (unsigned j = 0; j < 16; ++j) { const unsigned c = xb_ld(&bar[XB_XCNT(j)]); sum += c; cnt += (c > 0u) ? 1u : 0u; mine = (j == x) ? c : mine; }
        if (sum == G) break;
        __builtin_amdgcn_s_sleep(1);
        if ((++sp & 255u) == 0u) { if (xb_ld(&bar[XB_TMO])) break; if (sp > XB_SPIN_CAP) { atomicAdd(&bar[XB_TMO], 1u); break; } }
    }
    nloc = mine > 0u ? mine : 1u; nx = cnt > 0u ? cnt : 1u;
}
__device__ __forceinline__ void xcd_barrier(const XcdBarrier& b) {
    asm volatile("s_waitcnt vmcnt(0)" ::: "memory");
    __syncthreads();
    if (threadIdx.x == 0) {
        unsigned* bar = b.bar;
        __builtin_amdgcn_s_waitcnt(0);
        unsigned nloc = b.st[0], nx = b.st[1];
        if (nloc == 0u) { xcd_barrier_complete(bar, b.x, nloc, nx); b.st[0] = nloc; b.st[1] = nx; }
        const unsigned old = xb_add(&bar[XB_XSUB(b.x)], 1u);
        const unsigned gen = old / nloc;
        if (old + 1u == (gen + 1u) * nloc) {
            __builtin_amdgcn_fence(__ATOMIC_RELEASE, "agent");
            asm volatile("s_waitcnt vmcnt(0)" ::: "memory");
            const unsigned og = xb_add(&bar[XB_TOP], 1u);
            const unsigned tg = og / nx;
            if (og + 1u == (tg + 1u) * nx) xb_add(&bar[XB_TOPGEN], 1u);
            else XB_SPIN(xb_ld(&bar[XB_TOPGEN]) == tg, bar);
            __builtin_amdgcn_fence(__ATOMIC_ACQUIRE, "agent");
            xb_add(&bar[XB_XGEN(b.x)], 1u);
            asm volatile("s_waitcnt vmcnt(0)" ::: "memory");
        } else {
            XB_SPIN(xb_ld(&bar[XB_XGEN(b.x)]) == gen, bar);
            __builtin_amdgcn_fence(__ATOMIC_ACQUIRE, "agent");
            asm volatile("s_waitcnt vmcnt(0)" ::: "memory");
        }
    }
    __syncthreads();
}

constexpr int NPH = 17;
constexpr int PREP_MOD = 192, PREP_Z = 64, PREP_R = 1, PREP_C = 384;

#ifndef REP
#define REP 0
#endif
__device__ __forceinline__ int nrep(int ph) {
    int r = 1;
    const int l = ph >= 10 ? 1 : 0, lp = l == 0 ? ph - 1 : ph - 10;
    if ((REP & 16) && ph == 0) r = 2;
    if (ph > 0) {
        const bool up = l == 0 ? (lp == 7) : (lp == 5);
        if ((REP & 1) && up) r = 2;
        if ((REP & 2) && lp == 2 && l == 1) r = 2;
        if ((REP & 32) && lp == 2 && l == 0) r = 2;
        const bool nrm = lp == 0 || (l == 0 ? lp == 6 : lp == 4);
        if ((REP & 4) && nrm) r = 2;
        if ((REP & 64) && l == 0 && lp == 3) r = 2;
    }
    return r;
}
__global__ void __launch_bounds__(NTHREADS, 2) mega(Params P) {
    unsigned char* ws = P.ws;
    bf16_t* H = (bf16_t*)(ws + WS_H);
    bf16_t* MIX = H;
    bf16_t* QKV = (bf16_t*)(ws + WS_QKV);
    bf16_t* Ub = (bf16_t*)(ws + WS_U);
    bf16_t* GV = (bf16_t*)(ws + WS_GV);
    const float* MOD = (const float*)(ws + WS_MOD);
    float* out = P.out;
    extern __shared__ __attribute__((aligned(16))) unsigned char smem_k[];
    volatile LAS unsigned* bst = (volatile LAS unsigned*)(smem_k + 131072);
    if (threadIdx.x < 2) bst[threadIdx.x] = 0u;
    __syncthreads();
    const XcdBarrier xb = xcd_barrier_post((unsigned*)(ws + WS_BAR), bst);
    for (int ph = P.ph_lo; ph < P.ph_hi; ++ph) {
        if (ph > P.ph_lo) { if (P.use_cg) cg::this_grid().sync(); else xcd_barrier(xb); if (REP & 8) xcd_barrier(xb); }
        for (int rep = 0; rep < nrep(ph); ++rep) {
        if (ph == 0 && !EN_MISC) continue;
        if (ph == 0) {
            constexpr int tot = PREP_MOD + PREP_Z + PREP_R + PREP_C + 736;
            for (int t = blockIdx.x; t < tot; t += gridDim.x) {
                int q = t;
                if (q < PREP_MOD) { prep_mod(P, q); continue; } q -= PREP_MOD;
                if (q < PREP_Z) { prep_zoh(P, q); continue; } q -= PREP_Z;
                if (q < PREP_R) { prep_rope(P); continue; } q -= PREP_R;
                if (q < PREP_C) { prep_cache(P, q); continue; } q -= PREP_C;
                if (q < 128) { prep_wtile<false>(P.in[18], (bf16_t*)(ws + WS_WINE), 1024, 2048, q); continue; } q -= 128;
                if (q < 64) { prep_wtile<false>(P.in[19], (bf16_t*)(ws + WS_WOUTE), 1024, 1024, q); continue; } q -= 64;
                if (q < 16) { prep_wtile<false>(P.in[31], (bf16_t*)(ws + WS_WGLU), 512, 512, q); continue; } q -= 16;
                if (q < 352) { prep_wtile<true>(P.in[14], (bf16_t*)(ws + WS_WUP), 1024, 5632, q); continue; } q -= 352;
                prep_wtile<false>(P.in[17], (bf16_t*)(ws + WS_WDOWN), 2816, 1024, q);
            }
            continue;
        }
        const int l = ph >= 10 ? 1 : 0;
        const int lp = l == 0 ? ph - 1 : ph - 10;
        const float* modl = MOD + (size_t)l * 5 * 6144;
        const float* xc0 = P.in[0]; const float* xl0 = P.in[1];
        const float* xcd = out + O_Y; const float* xld = out + O_Y + (size_t)NCTX * DM;
        if (lp == 0) {
            if (l == 0) norm_phase(P, 0, 0, xc0, xl0); else norm_phase(P, 1, 0, xcd, xld);
        } else if (lp == 1) {
            if (l == 0) {
                EpiInEven e{QKV, Ub, P.in[20], P.in[21], out + O_NAK, out + O_NAV};
                run_gemm<0>(H, DM, (const bf16_t*)(ws + WS_WINE), DM, 2048, 0, NTOK, e);
            } else {
                EpiInOdd e{QKV, P.in[35], P.in[36], (const float*)(ws + WS_ROPE), out + O_GQK, out + O_GQV};
                run_gemm<1>(H, DM, (const bf16_t*)(ws + WS_WINO), DM, 1536, 0, NTOK, e);
            }
        } else if (lp == 2) {
            if (l == 0) {
                for (int t = blockIdx.x; t < 256 + 128 + 640; t += gridDim.x) {
                    if (t < 256) {
                        const int r8 = t & 7, h = (t >> 3) & 7, b = t >> 6;
                        const int r0 = r8 * 8;
                        const int rb0 = min(max(r0 - 4, 0), 56), rb1 = min(max(r0 + 7 - 4, 0), 56) + 7;
                        const size_t tok0 = (size_t)NCTX + (size_t)b * 4096;
                        AttnUnit u;
                        u.Q = QKV + (tok0 + r0 * 64) * 1536 + h * 64; u.qs = 1536;
                        u.K1 = QKV + (tok0 + rb0 * 64) * 1536 + 512 + h * 64; u.V1 = QKV + (tok0 + rb0 * 64) * 1536 + 1024 + h * 64; u.s1 = 1536; u.n1 = rb1 - rb0 + 1;
                        u.K2 = (const bf16_t*)(ws + WS_NAK) + (size_t)b * 256 * 512 + h * 64; u.V2 = (const bf16_t*)(ws + WS_NAV) + (size_t)b * 256 * 512 + h * 64; u.s2 = 512; u.n2 = 4;
                        u.O = MIX + (tok0 + r0 * 64) * DM + h * 64; u.os = DM;
                        u.kind = 1; u.r0 = r0; u.rb0 = rb0; u.rpb = P.in[22] + h * 465;
                        u.gq = P.in[20]; u.gk = P.in[21]; u.kmax = (const unsigned*)(ws + WS_KMAX); u.kw = 0;
                        if (EN_ATT) attn_unit64<true>(u);
                    } else if (t < 384) {
                        const int q = t - 256, h = q & 7, s = q >> 3;
                        const size_t tok0 = (size_t)s * 256;
                        AttnUnit u;
                        u.Q = QKV + tok0 * 1536 + h * 64; u.qs = 1536;
                        u.K1 = QKV + tok0 * 1536 + 512 + h * 64; u.V1 = QKV + tok0 * 1536 + 1024 + h * 64; u.s1 = 1536; u.n1 = 4;
                        u.K2 = u.K1; u.V2 = u.V1; u.s2 = 1536; u.n2 = 0;
                        u.O = MIX + tok0 * DM + h * 64; u.os = DM;
                        u.kind = 0; u.r0 = 0; u.rb0 = 0; u.rpb = P.in[22];
                        if (EN_ATT) attn_unit_old(u);
                    } else {
                        if (EN_SSM) ssm_task<false>(P, t - 384);
                    }
                }
            } else {
                for (int t = blockIdx.x; t < 512 + 256; t += gridDim.x) {
                    AttnUnit u;
                    if (t < 512) {
                        const int qt = t & 7, h = (t >> 3) & 15, b = t >> 7, kvh = h >> 2;
                        const size_t tok0 = (size_t)NCTX + (size_t)b * 4096;
                        u.Q = QKV + (tok0 + qt * 512) * 1536 + h * 64; u.qs = 1536;
                        u.K1 = QKV + tok0 * 1536 + 1024 + kvh * 64; u.V1 = QKV + tok0 * 1536 + 1280 + kvh * 64; u.s1 = 1536; u.n1 = 64;
                        u.K2 = (const bf16_t*)(ws + WS_GQK) + (size_t)b * 256 * 256 + kvh * 64; u.V2 = (const bf16_t*)(ws + WS_GQV) + (size_t)b * 256 * 256 + kvh * 64; u.s2 = 256; u.n2 = 4;
                        u.O = MIX + (tok0 + qt * 512) * DM + h * 64; u.os = DM;
                        u.kind = 0; u.r0 = 0; u.rb0 = 0; u.rpb = P.in[22];
                        u.gq = P.in[35]; u.gk = P.in[36]; u.kmax = (const unsigned*)(ws + WS_KMAX); u.kw = 1;
                        if (EN_ATT) attn_unit64<false>(u);
                    } else {
                        const int q = t - 512, h = q & 15, s = q >> 4, kvh = h >> 2;
                        const size_t tok0 = (size_t)s * 256;
                        u.Q = QKV + tok0 * 1536 + h * 64; u.qs = 1536;
                        u.K1 = QKV + tok0 * 1536 + 1024 + kvh * 64; u.V1 = QKV + tok0 * 1536 + 1280 + kvh * 64; u.s1 = 1536; u.n1 = 4;
                        u.K2 = u.K1; u.V2 = u.V1; u.s2 = 1536; u.n2 = 0;
                        u.O = MIX + tok0 * DM + h * 64; u.os = DM;
                        u.kind = 0; u.r0 = 0; u.rb0 = 0; u.rpb = P.in[22];
                        if (EN_ATT) attn_unit_old(u);
                    }
                }
            }
        } else if (lp == 3) {
            if (l == 0) {
                carry_phase(P);
                xcd_barrier(xb);
                for (int t = blockIdx.x; t < 640; t += gridDim.x) { __syncthreads(); if (EN_SSM) ssm_task<true>(P, t); }
                if (blockIdx.x >= 128 && EN_MISC) {
                    for (int q0 = (int)blockIdx.x - 128; q0 < 688; q0 += 128) {
                        int q = q0;
                        if (q < 96) { prep_wtile<false>(P.in[33], (bf16_t*)(ws + WS_WINO), 1024, 1536, q); continue; } q -= 96;
                        if (q < 64) { prep_wtile<false>(P.in[34], (bf16_t*)(ws + WS_WOUTO), 1024, 1024, q); continue; } q -= 64;
                        if (q < 352) { prep_wtile<true>(P.in[14] + (size_t)1024 * 5632, (bf16_t*)(ws + WS_WUP) + (size_t)5632 * 1024, 1024, 5632, q); continue; } q -= 352;
                        prep_wtile<false>(P.in[17] + (size_t)2816 * 1024, (bf16_t*)(ws + WS_WDOWN) + (size_t)1024 * 2816, 2816, 1024, q);
                    }
                }
            } else {
                EpiResid1 e{xcd, xld, out + O_Y, modl, 2048};
                run_gemm_n128(MIX, DM, (const bf16_t*)(ws + WS_WOUTO), DM, 1024, e);
            }
        } else if (l == 0 && lp == 4) {
            EpiGlu e{(const bf16_t*)(ws + WS_YG), MIX, P.in[32]};
            run_gemm<3>((const bf16_t*)(ws + WS_YG), 512, (const bf16_t*)(ws + WS_WGLU), 512, 512, 0, NTOK, e);
        } else if (l == 0 && lp == 5) {
            EpiResid1 e{xc0, xl0, out + O_Y, modl, 2048};
            run_gemm_n128(MIX, DM, (const bf16_t*)(ws + WS_WOUTE), DM, 1024, e);
        } else {
            const int fp = l == 0 ? lp - 6 : lp - 4;
            bf16_t* ACT = (bf16_t*)(ws + WS_GV);
            if (fp == 0) {
                norm_phase(P, l, 1, xcd, xld);
            } else if (fp == 1) {
                EpiUpConv e{ACT, P.in[15] + (size_t)l * 3 * DFF, P.in[16] + (size_t)l * DFF};
                run_gemm_up(H, (const bf16_t*)(ws + WS_WUP) + (size_t)l * 5632 * 1024, e);
            } else {
                EpiResid1 e{xcd, xld, out + O_Y, modl, 5120};
                run_gemm_n128(ACT, DFF, (const bf16_t*)(ws + WS_WDOWN) + (size_t)l * 1024 * 2816, DFF, 1024, e);
            }
        }
        }
    }
}

extern "C" void kernel_launch(void* const* d_in, const int* in_sizes, int n_in, void* d_out, int out_size, void* d_ws, size_t ws_size, hipStream_t stream) {
    static int grid = 0;
    if (grid == 0) {
        int dev = 0, cus = 0, per_cu = 0;
        hipGetDevice(&dev);
        hipDeviceGetAttribute(&cus, hipDeviceAttributeMultiprocessorCount, dev);
        hipFuncSetAttribute((const void*)mega, hipFuncAttributeMaxDynamicSharedMemorySize, LDS_BYTES);
        hipOccupancyMaxActiveBlocksPerMultiprocessor(&per_cu, (const void*)mega, NTHREADS, LDS_BYTES);
        if (per_cu < 1) per_cu = 1;
        grid = cus * per_cu;
        if (n_in != 37 || ws_size < 240 * MiB) fprintf(stderr, "kernel_launch: unexpected n_in %d / ws %zu\n", n_in, ws_size);
    }
    Params p{};
    for (int i = 0; i < 37; ++i) p.in[i] = (const float*)d_in[i];
    p.out = (float*)d_out; p.ws = (unsigned char*)d_ws;
    p.use_cg = 0; p.pad = 0;
    (void)hipMemsetAsync((unsigned char*)d_ws + WS_BAR, 0, XCD_BAR_WORDS * 4 + 256, stream);
#if COOP
    p.ph_lo = 0; p.ph_hi = NPH;
    void* args[] = {&p};
    hipError_t e = hipLaunchCooperativeKernel((const void*)mega, dim3(grid), dim3(NTHREADS), args, LDS_BYTES, stream);
    if (e != hipSuccess) fprintf(stderr, "cooperative launch failed: %s (grid %d)\n", hipGetErrorString(e), grid);
#else
    for (int ph = 0; ph < NPH; ++ph) {
        p.ph_lo = ph; p.ph_hi = ph + 1;
        hipLaunchKernelGGL(mega, dim3(grid), dim3(NTHREADS), LDS_BYTES, stream, p);
    }
#endif
}
```

```cpp
#include <hip/hip_runtime.h>
#include <hip/hip_cooperative_groups.h>
#include <cstdio>
#include <cstdint>
namespace cg = cooperative_groups;

#ifndef COOP
#define COOP 1
#endif
#ifndef EN
#define EN 0xff
#endif
#define EN_GEMM (EN & 1)
#define EN_ATT (EN & 2)
#define EN_SSM (EN & 4)
#define EN_MISC (EN & 8)

typedef unsigned short bf16_t;
typedef short bf16x8 __attribute__((ext_vector_type(8)));
typedef short s16x4 __attribute__((ext_vector_type(4)));
typedef float f32x4 __attribute__((ext_vector_type(4)));
typedef float f32x2 __attribute__((ext_vector_type(2)));
typedef float f32x16 __attribute__((ext_vector_type(16)));
typedef unsigned u32x4 __attribute__((ext_vector_type(4)));
typedef unsigned u32x2 __attribute__((ext_vector_type(2)));
#define LAS __attribute__((address_space(3)))

constexpr int DM = 1024, NTOK = 20480, NCTX = 4096, DFF = 2816;
constexpr float EPSN = 1e-6f;
constexpr float QSC = 0.125f * 1.4426950408889634f;
constexpr int NTHREADS = 512;
constexpr int LDS_BYTES = 131072 + 256 + 4096;

constexpr size_t O_Y = 0, O_NAK = 20971520, O_NAV = 23068672, O_SRE = 25165824, O_SIM = 25231360, O_GQK = 25296896, O_GQV = 26345472;

constexpr size_t MiB = 1u << 20;
constexpr size_t WS_MOD = 0;
constexpr size_t WS_BAR = 240 * 1024;
constexpr size_t WS_KMAX = 240 * 1024 + 13824;
constexpr size_t WS_ROPE = 256 * 1024;
constexpr size_t WS_SSA = 272 * 1024;
constexpr size_t WS_SSA64 = 304 * 1024;
constexpr size_t WS_BM = 512 * 1024;
constexpr size_t WS_CM = 768 * 1024;
constexpr size_t WS_NAK = 1 * MiB, WS_NAV = 2 * MiB, WS_GQK = 3 * MiB, WS_GQV = 3 * MiB + 512 * 1024;
constexpr size_t WS_END = 4 * MiB;
constexpr size_t WS_WINE = 14 * MiB, WS_WOUTE = 18 * MiB, WS_WGLU = 20 * MiB, WS_WINO = 20 * MiB + 512 * 1024, WS_WOUTO = 23 * MiB + 512 * 1024;
constexpr size_t WS_WUP = 25 * MiB + 512 * 1024;
constexpr size_t WS_WDOWN = 47 * MiB + 512 * 1024;
constexpr size_t WS_H = 59 * MiB;
constexpr size_t WS_GV = 100 * MiB;
constexpr size_t WS_QKV = 100 * MiB;
constexpr size_t WS_U = 160 * MiB;
constexpr size_t WS_YG = 180 * MiB;
constexpr int FFN_SPLIT = 12288;

struct Params {
    const float* in[37];
    float* out;
    unsigned char* ws;
    int ph_lo, ph_hi, use_cg, pad;
};

__device__ __forceinline__ unsigned pk2(float lo, float hi) { unsigned r; asm("v_cvt_pk_bf16_f32 %0, %1, %2" : "=v"(r) : "v"(lo), "v"(hi)); return r; }
__device__ __forceinline__ float bf2f(unsigned short h) { return __uint_as_float(((unsigned)h) << 16); }
__device__ __forceinline__ float bflo(unsigned w) { return __uint_as_float(w << 16); }
__device__ __forceinline__ float bfhi(unsigned w) { return __uint_as_float(w & 0xffff0000u); }
__device__ __forceinline__ float siluf(float x) { return x * __builtin_amdgcn_rcpf(1.0f + __builtin_amdgcn_exp2f(-1.4426950408889634f * x)); }
__device__ __forceinline__ float sigmf(float x) { return __builtin_amdgcn_rcpf(1.0f + __builtin_amdgcn_exp2f(-1.4426950408889634f * x)); }
__device__ __forceinline__ float gelu_tanh(float x) { const float u = 0.7978845608028654f * (x + 0.044715f * x * x * x); const float e = __builtin_amdgcn_exp2f(2.8853900817779268f * u); const float t = 1.0f - 2.0f * __builtin_amdgcn_rcpf(e + 1.0f); return 0.5f * x * (1.0f + t); }
__device__ __forceinline__ int otid() { int t = threadIdx.x; asm volatile("" : "+v"(t)); return t; }
__device__ __forceinline__ int condof(int row) { return row < NCTX ? 0 : 1 + ((row - NCTX) >> 12); }
__device__ __forceinline__ float wave_sum(float v) {
#pragma unroll
    for (int o = 32; o >= 1; o >>= 1) v += __shfl_xor(v, o);
    return v;
}

constexpr int BM = 256, BK = 64, HALF = 128, HT = HALF * BK;
__device__ __forceinline__ int lds_byte(int r, int c) { int st = (r >> 4) * 2 + (c >> 5), rr = r & 15, cc = c & 31, ob = rr * 64 + cc * 2; return st * 1024 + (ob ^ (((ob >> 9) & 1) << 5)); }
__device__ __forceinline__ void stage_rc(int b, int& R, int& C) { int st = b / 1024, sb = b % 1024, swz = sb ^ (((sb >> 9) & 1) << 5); R = (st >> 1) * 16 + swz / 64; C = (st & 1) * 32 + (swz % 64) / 2; }

struct Unit { int pm, pn, rb, ks, sp; };
struct Gemm { const bf16_t* A; const bf16_t* Bt; int lda, K, Kpart; };
struct Order {
    int pm0, nM, nN, ntile, G, c, ovl, ksplit;
    __device__ __forceinline__ bool next(int i, Unit& u) const {
        const int L0 = i * G + c; if (L0 >= ntile * ksplit) return false;
        const int L = L0 % ntile; u.ks = L0 / ntile;
        int wgid = L; { const int q = ntile / 8, r = ntile % 8, xcd = wgid % 8, off = wgid / 8; wgid = (xcd < r ? xcd * (q + 1) : r * (q + 1) + (xcd - r) * q) + off; }
        const int nig = 8 * nN, gid = wgid / nig, fm = gid * 8, gsz = (nM - fm) < 8 ? (nM - fm) : 8;
        u.pm = pm0 + fm + ((wgid % nig) % gsz); u.pn = (wgid % nig) / gsz;
        u.sp = 0;
        if (ovl && u.pm >= 16) { if (u.pm == 80) { u.rb = NCTX + 4063; u.sp = 1; } else { const int q = u.pm - 16, b = q >> 4, i = q & 15; u.rb = NCTX + 4096 * b + 254 * i - 1; } } else u.rb = u.pm * BM;
        return true;
    }
};
constexpr int HTB = HALF * BK * 2;
template <bool GATHER, class Epi>
__device__ __forceinline__ void gemm_phase(const Gemm g, const Order& S, const Epi& E) {
    extern __shared__ __attribute__((aligned(16))) unsigned char smem[];
    LAS unsigned char* lds = (LAS unsigned char*)smem;
    const int tid = otid(), wid = __builtin_amdgcn_readfirstlane(tid >> 6), lane = tid & 63, wr = wid >> 2, wc = wid & 3, fr = lane & 15, fq = lane >> 4;
    const int K = g.K, nt = g.Kpart / BK, lda = g.lda;
    const size_t kpb = (size_t)g.Kpart * 2;
    unsigned voffA[2], voffB[2];
#pragma unroll
    for (int i = 0; i < 2; ++i) { int R, C; stage_rc(tid * 16 + i * 8192, R, C); voffA[i] = (unsigned)(R * lda + C) * 2u; voffB[i] = (unsigned)(R * K + C) * 2u; }
    const size_t kstep = (size_t)(BK * 2);
    const size_t hstepA = (size_t)HALF * lda * 2, hstepB = (size_t)HALF * K * 2;
    const size_t tstepA = 2 * hstepA, tstepB = 2 * hstepB;
    const unsigned ldsw = (unsigned)wid * 1024u;
    const int aoff = lds_byte(wr * 64 + fr, fq * 8), boff = lds_byte(wc * 32 + fr, fq * 8);
#define PG8_SA(b, h) (((b) * 2 + (h)) * HTB)
#define PG8_SB(b, h) ((4 + (b) * 2 + (h)) * HTB)
#define PG8_STAGE(bufoff, gbase, voff) do { _Pragma("unroll") for (int _i = 0; _i < 2; ++_i) \
        __builtin_amdgcn_global_load_lds((const unsigned*)((const char*)(gbase) + (voff)[_i]), (LAS unsigned*)(lds + (bufoff) + ldsw + _i * 8192), 16, 0, 0); } while (0)
#define PG8_LDA(dst, b, h) do { _Pragma("unroll") for (int m = 0; m < 4; ++m) _Pragma("unroll") for (int k = 0; k < 2; ++k) dst[m][k] = *(const LAS bf16x8*)(lds + PG8_SA(b, h) + aoff + m * 2048 + k * 1024); } while (0)
#define PG8_LDB(dst, b, h) do { _Pragma("unroll") for (int n = 0; n < 2; ++n) _Pragma("unroll") for (int k = 0; k < 2; ++k) dst[n][k] = *(const LAS bf16x8*)(lds + PG8_SB(b, h) + boff + n * 2048 + k * 1024); } while (0)
#define PG8_MMA(ai, bj, At, Bt) do { __builtin_amdgcn_s_setprio(1); _Pragma("unroll") for (int m = 0; m < 4; ++m) _Pragma("unroll") for (int n = 0; n < 2; ++n) _Pragma("unroll") for (int k = 0; k < 2; ++k) \
        acc[ai][bj][m][n] = __builtin_amdgcn_mfma_f32_16x16x32_bf16(Bt[n][k], At[m][k], acc[ai][bj][m][n], 0, 0, 0); __builtin_amdgcn_s_setprio(0); } while (0)
#define PG8_WAIT_V(n) asm volatile("s_waitcnt vmcnt(" #n ")" ::: "memory")
#define PG8_WAIT_L(n) asm volatile("s_waitcnt lgkmcnt(" #n ")" ::: "memory")
#define PG8_BAR __builtin_amdgcn_s_barrier()
#define PG8_SCHED __builtin_amdgcn_sched_barrier(0)
    Unit cur, nxt; int ui = 0;
    if (!S.next(0, cur)) return;
    f32x4 acc[2][2][4][2];
#pragma unroll
    for (int a = 0; a < 2; ++a)
#pragma unroll
        for (int b = 0; b < 2; ++b)
#pragma unroll
            for (int m = 0; m < 4; ++m)
#pragma unroll
                for (int n = 0; n < 2; ++n) acc[a][b][m][n] = (f32x4){0.f, 0.f, 0.f, 0.f};
    bf16x8 At[4][2], B0[2][2], B1[2][2];
    const size_t rstepA = (size_t)lda * 2;
    const char* cA = (const char*)g.A + (size_t)cur.rb * rstepA + cur.ks * kpb; const char* cB = (const char*)g.Bt + (size_t)cur.pn * tstepB + cur.ks * kpb;
    unsigned vc[2]; size_t hc = hstepA;
#define PG8_VMAP(dst, hdst, issp) do { hdst = (issp) ? (size_t)8192 * lda * 2 : hstepA; _Pragma("unroll") for (int i_ = 0; i_ < 2; ++i_) { int R_, C_; stage_rc(tid * 16 + i_ * 8192, R_, C_); \
        const int Rm_ = (issp) ? ((R_ >> 6) * 4096 + (R_ & 63)) : R_; dst[i_] = (unsigned)(Rm_ * lda + C_) * 2u; } } while (0)
    PG8_VMAP(vc, hc, (GATHER && cur.sp));
    PG8_STAGE(PG8_SB(0, 0), cB, voffB); PG8_STAGE(PG8_SB(0, 1), cB + hstepB, voffB); PG8_STAGE(PG8_SA(0, 0), cA, vc); PG8_STAGE(PG8_SA(0, 1), cA + hc, vc);
    if (wr == 1) PG8_BAR;
    PG8_WAIT_V(2); PG8_BAR;
    PG8_STAGE(PG8_SB(1, 0), cB + kstep, voffB); PG8_STAGE(PG8_SA(1, 0), cA + kstep, vc); PG8_STAGE(PG8_SB(1, 1), cB + hstepB + kstep, voffB);
    PG8_WAIT_V(6); PG8_BAR;
    for (;;) {
        const bool has_next = S.next(ui + 1, nxt);
        const char* nA = has_next ? (const char*)g.A + (size_t)nxt.rb * rstepA + nxt.ks * kpb : cA; const char* nB = has_next ? (const char*)g.Bt + (size_t)nxt.pn * tstepB + nxt.ks * kpb : cB;
        for (int t = 0; t < nt; t += 2) {
            const bool last = (t == nt - 2);
            unsigned v2[2]; v2[0] = vc[0]; v2[1] = vc[1]; size_t h2 = hc;
            if (GATHER && last && has_next && nxt.sp != cur.sp) PG8_VMAP(v2, h2, nxt.sp);
            const char* a1 = cA + (size_t)(t + 1) * kstep;
            const char* a2 = last ? nA : cA + (size_t)(t + 2) * kstep; const char* b2 = last ? nB : cB + (size_t)(t + 2) * kstep;
            const char* a3 = a2 + kstep; const char* b3 = b2 + kstep;
            PG8_LDB(B0, 0, 0); PG8_LDB(B1, 0, 1); PG8_SCHED; PG8_LDA(At, 0, 0); PG8_STAGE(PG8_SA(1, 1), a1 + hc, vc);
            PG8_WAIT_V(8); PG8_WAIT_L(0); PG8_BAR; PG8_MMA(0, 0, At, B0); PG8_MMA(0, 1, At, B1); PG8_BAR; PG8_SCHED;
            PG8_LDA(At, 0, 1); PG8_STAGE(PG8_SB(0, 0), b2, voffB); PG8_STAGE(PG8_SB(0, 1), b2 + hstepB, voffB); PG8_STAGE(PG8_SA(0, 0), a2, v2);
            PG8_WAIT_V(8); PG8_WAIT_L(0); PG8_BAR; PG8_MMA(1, 0, At, B0); PG8_MMA(1, 1, At, B1); PG8_BAR; PG8_SCHED;
            PG8_LDB(B0, 1, 0); PG8_LDB(B1, 1, 1); PG8_SCHED; PG8_LDA(At, 1, 0); PG8_STAGE(PG8_SA(0, 1), a2 + h2, v2);
            PG8_WAIT_V(8); PG8_WAIT_L(0); PG8_BAR; PG8_MMA(0, 0, At, B0); PG8_MMA(0, 1, At, B1); PG8_BAR; PG8_SCHED;
            PG8_LDA(At, 1, 1); PG8_STAGE(PG8_SB(1, 0), b3, voffB); PG8_STAGE(PG8_SB(1, 1), b3 + hstepB, voffB); PG8_STAGE(PG8_SA(1, 0), a3, v2);
            PG8_WAIT_V(8); PG8_WAIT_L(0); PG8_BAR; PG8_MMA(1, 0, At, B0); PG8_MMA(1, 1, At, B1); PG8_BAR; PG8_SCHED;
        }
        if (wr == 0) PG8_BAR;
        E(acc, cur, cur.rb, cur.pn * BM, wr, wc, fr, fq);
        if (!has_next) break;
#pragma unroll
        for (int a = 0; a < 2; ++a)
#pragma unroll
            for (int b = 0; b < 2; ++b)
#pragma unroll
                for (int m = 0; m < 4; ++m)
#pragma unroll
                    for (int n = 0; n < 2; ++n) acc[a][b][m][n] = (f32x4){0.f, 0.f, 0.f, 0.f};
        cur = nxt; cA = nA; cB = nB; ++ui; if (GATHER) PG8_VMAP(vc, hc, cur.sp);
        if (wr == 1) PG8_BAR;
    }
    PG8_WAIT_V(0);
    PG8_BAR;
    __syncthreads();
}

template <class Epi>
__device__ __forceinline__ void gemm_phase_n128(const Gemm g, const Order& S, const Epi& E) {
    extern __shared__ __attribute__((aligned(16))) unsigned char smem[];
    LAS unsigned char* lds = (LAS unsigned char*)smem;
    const int tid = otid(), wid = __builtin_amdgcn_readfirstlane(tid >> 6), lane = tid & 63, wr = wid >> 2, wc = wid & 3, fr = lane & 15, fq = lane >> 4;
    const int K = g.K, nt = g.Kpart / BK, lda = g.lda;
    const size_t kpb = (size_t)g.Kpart * 2;
    unsigned voffA[2], voffB[2];
#pragma unroll
    for (int i = 0; i < 2; ++i) { int R, C; stage_rc(tid * 16 + i * 8192, R, C); voffA[i] = (unsigned)(R * lda + C) * 2u; voffB[i] = (unsigned)(R * K + C) * 2u; }
    const size_t kstep = (size_t)(BK * 2);
    const size_t hstepA = (size_t)HALF * lda * 2, hstepB = (size_t)HALF * K * 2;
    const size_t tstepA = 2 * hstepA, tstepB = 2 * hstepB;
    const unsigned ldsw = (unsigned)wid * 1024u;
    const int aoff = lds_byte(wr * 64 + fr, fq * 8), boff = lds_byte(wc * 32 + fr, fq * 8);
    Unit cur, nxt; int ui = 0;
    if (!S.next(0, cur)) return;
    f32x4 acc[2][1][4][2];
#pragma unroll
    for (int a = 0; a < 2; ++a)
#pragma unroll
            for (int m = 0; m < 4; ++m)
#pragma unroll
                for (int n = 0; n < 2; ++n) acc[a][0][m][n] = (f32x4){0.f, 0.f, 0.f, 0.f};
    bf16x8 At[4][2], B0[2][2];
    const size_t rstepA = (size_t)lda * 2;
    const char* cA = (const char*)g.A + (size_t)cur.rb * rstepA + cur.ks * kpb; const char* cB = (const char*)g.Bt + (size_t)cur.pn * hstepB + cur.ks * kpb;
    PG8_STAGE(PG8_SB(0, 0), cB, voffB); PG8_STAGE(PG8_SA(0, 0), cA, voffA); PG8_STAGE(PG8_SA(0, 1), cA + hstepA, voffA);
    if (wr == 1) PG8_BAR;
    PG8_WAIT_V(2); PG8_BAR;
    PG8_STAGE(PG8_SB(1, 0), cB + kstep, voffB); PG8_STAGE(PG8_SA(1, 0), cA + kstep, voffA);
    PG8_WAIT_V(4); PG8_BAR;
    for (;;) {
        const bool has_next = S.next(ui + 1, nxt);
        const char* nA = has_next ? (const char*)g.A + (size_t)nxt.rb * rstepA + nxt.ks * kpb : cA; const char* nB = has_next ? (const char*)g.Bt + (size_t)nxt.pn * hstepB + nxt.ks * kpb : cB;
        for (int t = 0; t < nt; t += 2) {
            const bool last = (t == nt - 2);
            const char* a1 = cA + (size_t)(t + 1) * kstep;
            const char* a2 = last ? nA : cA + (size_t)(t + 2) * kstep; const char* b2 = last ? nB : cB + (size_t)(t + 2) * kstep;
            const char* a3 = a2 + kstep; const char* b3 = b2 + kstep;
            PG8_LDB(B0, 0, 0); PG8_SCHED; PG8_LDA(At, 0, 0); PG8_STAGE(PG8_SA(1, 1), a1 + hstepA, voffA);
            PG8_WAIT_V(6); PG8_WAIT_L(0); PG8_BAR; PG8_MMA(0, 0, At, B0); PG8_BAR; PG8_SCHED;
            PG8_LDA(At, 0, 1); PG8_STAGE(PG8_SB(0, 0), b2, voffB); PG8_STAGE(PG8_SA(0, 0), a2, voffA);
            PG8_WAIT_V(6); PG8_WAIT_L(0); PG8_BAR; PG8_MMA(1, 0, At, B0); PG8_BAR; PG8_SCHED;
            PG8_LDB(B0, 1, 0); PG8_SCHED; PG8_LDA(At, 1, 0); PG8_STAGE(PG8_SA(0, 1), a2 + hstepA, voffA);
            PG8_WAIT_V(6); PG8_WAIT_L(0); PG8_BAR; PG8_MMA(0, 0, At, B0); PG8_BAR; PG8_SCHED;
            PG8_LDA(At, 1, 1); PG8_STAGE(PG8_SB(1, 0), b3, voffB); PG8_STAGE(PG8_SA(1, 0), a3, voffA);
            PG8_WAIT_V(6); PG8_WAIT_L(0); PG8_BAR; PG8_MMA(1, 0, At, B0); PG8_BAR; PG8_SCHED;
        }
        if (wr == 0) PG8_BAR;
        E(acc, cur, cur.rb, cur.pn * HALF, wr, wc, fr, fq);
        if (!has_next) break;
#pragma unroll
        for (int a = 0; a < 2; ++a)
#pragma unroll
                for (int m = 0; m < 4; ++m)
#pragma unroll
                    for (int n = 0; n < 2; ++n) acc[a][0][m][n] = (f32x4){0.f, 0.f, 0.f, 0.f};
        cur = nxt; cA = nA; cB = nB; ++ui;
        if (wr == 1) PG8_BAR;
    }
    PG8_WAIT_V(0);
    PG8_BAR;
    __syncthreads();
}

#undef PG8_SA
#undef PG8_SB

typedef f32x4 AccT[2][2][4][2];

struct EpiInEven {
    bf16_t* QKV; bf16_t* U; const float* qg; const float* kg; float* ok; float* ov;
    __device__ __forceinline__ void operator()(AccT& acc, const Unit& u, int brow, int bcol, int wr, int wc, int fr, int fq) const {
        const int hs = (bcol >> 6) + wc;
        const float* g = hs < 8 ? qg : kg;
        f32x4 gv[2][2];
        if (hs < 16) {
#pragma unroll
            for (int bj = 0; bj < 2; ++bj)
#pragma unroll
                for (int n = 0; n < 2; ++n) gv[bj][n] = *(const f32x4*)(g + bj * 32 + n * 16 + fq * 4);
        }
#pragma unroll
        for (int ai = 0; ai < 2; ++ai)
#pragma unroll
            for (int m = 0; m < 4; ++m) {
                const int row = brow + ai * 128 + wr * 64 + m * 16 + fr;
                f32x4 v[2][2];
#pragma unroll
                for (int bj = 0; bj < 2; ++bj)
#pragma unroll
                    for (int n = 0; n < 2; ++n) v[bj][n] = acc[ai][bj][m][n];
                if (hs < 16) {
                    float ss = 0.f;
#pragma unroll
                    for (int bj = 0; bj < 2; ++bj)
#pragma unroll
                        for (int n = 0; n < 2; ++n) ss += v[bj][n][0] * v[bj][n][0] + v[bj][n][1] * v[bj][n][1] + v[bj][n][2] * v[bj][n][2] + v[bj][n][3] * v[bj][n][3];
                    ss += __shfl_xor(ss, 16); ss += __shfl_xor(ss, 32);
                    const float rstd = rsqrtf(ss * (1.0f / 64.0f) + EPSN);
#pragma unroll
                    for (int bj = 0; bj < 2; ++bj)
#pragma unroll
                        for (int n = 0; n < 2; ++n) v[bj][n] = v[bj][n] * rstd * gv[bj][n] * (hs < 8 ? QSC : 1.0f);
                }
#pragma unroll
                for (int bj = 0; bj < 2; ++bj)
#pragma unroll
                    for (int n = 0; n < 2; ++n) {
                        const int d = bj * 32 + n * 16 + fq * 4;
                        u32x2 w; w.x = pk2(v[bj][n][0], v[bj][n][1]); w.y = pk2(v[bj][n][2], v[bj][n][3]);
                        if (hs < 24) *(u32x2*)(QKV + (size_t)row * 1536 + hs * 64 + d) = w;
                        else *(u32x2*)(U + (size_t)row * 512 + (hs - 24) * 64 + d) = w;
                        if (row < NCTX) {
                            if (hs >= 8 && hs < 16) *(f32x4*)(ok + (size_t)row * 512 + (hs - 8) * 64 + d) = v[bj][n];
                            else if (hs >= 16 && hs < 24) *(f32x4*)(ov + (size_t)row * 512 + (hs - 16) * 64 + d) = v[bj][n];
                        }
                    }
            }
    }
};

struct EpiInOdd {
    bf16_t* QKV; const float* qg; const float* kg; const float* rope; float* ok; float* ov;
    __device__ __forceinline__ void operator()(AccT& acc, const Unit& u, int brow, int bcol, int wr, int wc, int fr, int fq) const {
        const int hs = (bcol >> 6) + wc;
        const float* g = hs < 16 ? qg : kg;
        f32x4 gv[2][2];
        if (hs < 20) {
#pragma unroll
            for (int bj = 0; bj < 2; ++bj)
#pragma unroll
                for (int n = 0; n < 2; ++n) gv[bj][n] = *(const f32x4*)(g + bj * 32 + n * 16 + fq * 4);
        }
#pragma unroll
        for (int ai = 0; ai < 2; ++ai)
#pragma unroll
            for (int m = 0; m < 4; ++m) {
                const int row = brow + ai * 128 + wr * 64 + m * 16 + fr;
                f32x4 v[2][2];
#pragma unroll
                for (int bj = 0; bj < 2; ++bj)
#pragma unroll
                    for (int n = 0; n < 2; ++n) v[bj][n] = acc[ai][bj][m][n];
                if (hs < 20) {
                    float ss = 0.f;
#pragma unroll
                    for (int bj = 0; bj < 2; ++bj)
#pragma unroll
                        for (int n = 0; n < 2; ++n) ss += v[bj][n][0] * v[bj][n][0] + v[bj][n][1] * v[bj][n][1] + v[bj][n][2] * v[bj][n][2] + v[bj][n][3] * v[bj][n][3];
                    ss += __shfl_xor(ss, 16); ss += __shfl_xor(ss, 32);
                    const float rstd = rsqrtf(ss * (1.0f / 64.0f) + EPSN);
#pragma unroll
                    for (int bj = 0; bj < 2; ++bj)
#pragma unroll
                        for (int n = 0; n < 2; ++n) v[bj][n] = v[bj][n] * rstd * gv[bj][n];
                    if (row >= NCTX) {
                        const int t = (row - NCTX) & 4095;
#pragma unroll
                        for (int bj = 0; bj < 2; ++bj) {
                            const int pos = bj == 0 ? (t >> 6) : (t & 63);
                            const float* rp = rope + (pos * 16 + fq * 4) * 2;
                            const f32x4 cs0 = *(const f32x4*)rp, cs1 = *(const f32x4*)(rp + 4);
                            const f32x4 cc = (f32x4){cs0[0], cs0[2], cs1[0], cs1[2]}, sn = (f32x4){cs0[1], cs0[3], cs1[1], cs1[3]};
#pragma unroll
                            for (int j = 0; j < 4; ++j) {
                                const float x1 = v[bj][0][j], x2 = v[bj][1][j];
                                v[bj][0][j] = x1 * cc[j] - x2 * sn[j];
                                v[bj][1][j] = x1 * sn[j] + x2 * cc[j];
                            }
                        }
                    }
                    if (hs < 16) {
#pragma unroll
                        for (int bj = 0; bj < 2; ++bj)
#pragma unroll
                            for (int n = 0; n < 2; ++n) v[bj][n] = v[bj][n] * QSC;
                    }
                }
#pragma unroll
                for (int bj = 0; bj < 2; ++bj)
#pragma unroll
                    for (int n = 0; n < 2; ++n) {
                        const int d = bj * 32 + n * 16 + fq * 4;
                        u32x2 w; w.x = pk2(v[bj][n][0], v[bj][n][1]); w.y = pk2(v[bj][n][2], v[bj][n][3]);
                        *(u32x2*)(QKV + (size_t)row * 1536 + hs * 64 + d) = w;
                        if (row < NCTX) {
                            if (hs >= 16 && hs < 20) *(f32x4*)(ok + (size_t)row * 256 + (hs - 16) * 64 + d) = v[bj][n];
                            else if (hs >= 20) *(f32x4*)(ov + (size_t)row * 256 + (hs - 20) * 64 + d) = v[bj][n];
                        }
                    }
            }
    }
};

struct EpiResid {
    const float* xin_ctx; const float* xin_lat; float* xout; const float* mod; int goff;
    __device__ __forceinline__ void operator()(AccT& acc, const Unit& u, int brow, int bcol, int wr, int wc, int fr, int fq) const {
#pragma unroll
        for (int ai = 0; ai < 2; ++ai)
#pragma unroll
            for (int m = 0; m < 4; ++m) {
                const int row = brow + ai * 128 + wr * 64 + m * 16 + fr;
                const float* xi = row < NCTX ? xin_ctx + (size_t)row * DM : xin_lat + (size_t)(row - NCTX) * DM;
                const float* gp = mod + condof(row) * 6144 + goff;
#pragma unroll
                for (int bj = 0; bj < 2; ++bj)
#pragma unroll
                    for (int n = 0; n < 2; ++n) {
                        const int c = bcol + wc * 64 + bj * 32 + n * 16 + fq * 4;
                        const f32x4 x = *(const f32x4*)(xi + c), gg = *(const f32x4*)(gp + c);
                        *(f32x4*)(xout + (size_t)row * DM + c) = x + gg * acc[ai][bj][m][n];
                    }
            }
    }
};

typedef f32x4 AccT1[2][1][4][2];
struct EpiResid1 {
    const float* xin_ctx; const float* xin_lat; float* xout; const float* mod; int goff;
    __device__ __forceinline__ void operator()(AccT1& acc, const Unit& u, int brow, int bcol, int wr, int wc, int fr, int fq) const {
        const int cbase = (u.pn >> 1) * 256 + wc * 64 + (u.pn & 1) * 32 + fq * 4;
#pragma unroll
        for (int ai = 0; ai < 2; ++ai)
#pragma unroll
            for (int m = 0; m < 4; ++m) {
                const int row = brow + ai * 128 + wr * 64 + m * 16 + fr;
                const float* xi = row < NCTX ? xin_ctx + (size_t)row * DM : xin_lat + (size_t)(row - NCTX) * DM;
                const float* gp = mod + condof(row) * 6144 + goff;
#pragma unroll
                for (int n = 0; n < 2; ++n) {
                    const int c = cbase + n * 16;
                    const f32x4 x = *(const f32x4*)(xi + c), gg = *(const f32x4*)(gp + c);
                    *(f32x4*)(xout + (size_t)row * DM + c) = x + gg * acc[ai][0][m][n];
                }
            }
    }
};

struct EpiUp {
    bf16_t* GV; int rbase;
    __device__ __forceinline__ void operator()(AccT& acc, const Unit& u, int brow, int bcol, int wr, int wc, int fr, int fq) const {
#pragma unroll
        for (int ai = 0; ai < 2; ++ai)
#pragma unroll
            for (int m = 0; m < 4; ++m) {
                const int row = brow + ai * 128 + wr * 64 + m * 16 + fr - rbase;
#pragma unroll
                for (int bj = 0; bj < 2; ++bj)
#pragma unroll
                    for (int n = 0; n < 2; ++n) {
                        const int c = bcol + wc * 64 + bj * 32 + n * 16 + fq * 4;
                        u32x2 w; w.x = pk2(acc[ai][bj][m][n][0], acc[ai][bj][m][n][1]); w.y = pk2(acc[ai][bj][m][n][2], acc[ai][bj][m][n][3]);
                        *(u32x2*)(GV + (size_t)row * 5632 + c) = w;
                    }
            }
    }
};

struct EpiResidAtomic {
    float* x; const float* mod; int goff;
    __device__ __forceinline__ void operator()(AccT& acc, const Unit& u, int brow, int bcol, int wr, int wc, int fr, int fq) const {
#pragma unroll
        for (int ai = 0; ai < 2; ++ai)
#pragma unroll
            for (int m = 0; m < 4; ++m) {
                const int row = brow + ai * 128 + wr * 64 + m * 16 + fr;
                const float* gp = mod + condof(row) * 6144 + goff;
#pragma unroll
                for (int bj = 0; bj < 2; ++bj)
#pragma unroll
                    for (int n = 0; n < 2; ++n) {
                        const int c = bcol + wc * 64 + bj * 32 + n * 16 + fq * 4;
                        const f32x4 gg = *(const f32x4*)(gp + c);
                        float* xp = x + (size_t)row * DM + c;
#pragma unroll
                        for (int j = 0; j < 4; ++j) unsafeAtomicAdd(xp + j, gg[j] * acc[ai][bj][m][n][j]);
                    }
            }
    }
};

struct EpiGlu {
    const bf16_t* YG; bf16_t* MIX; const float* bias;
    __device__ __forceinline__ void operator()(AccT& acc, const Unit& u, int brow, int bcol, int wr, int wc, int fr, int fq) const {
#pragma unroll
        for (int ai = 0; ai < 2; ++ai)
#pragma unroll
            for (int m = 0; m < 4; ++m) {
                const int row = brow + ai * 128 + wr * 64 + m * 16 + fr;
#pragma unroll
                for (int bj = 0; bj < 2; ++bj)
#pragma unroll
                    for (int n = 0; n < 2; ++n) {
                        const int c = bcol + wc * 64 + bj * 32 + n * 16 + fq * 4;
                        const f32x4 bb = *(const f32x4*)(bias + c);
                        const u32x2 yw = *(const u32x2*)(YG + (size_t)row * 512 + c);
                        const f32x4 z = acc[ai][bj][m][n] + bb;
                        const float y0 = bflo(yw.x) * sigmf(z[0]), y1 = bfhi(yw.x) * sigmf(z[1]), y2 = bflo(yw.y) * sigmf(z[2]), y3 = bfhi(yw.y) * sigmf(z[3]);
                        u32x2 w; w.x = pk2(y0, y1); w.y = pk2(y2, y3);
                        *(u32x2*)(MIX + (size_t)row * DM + 512 + c) = w;
                    }
            }
    }
};


__device__ __forceinline__ float dpp_ror1(float v) { return __int_as_float(__builtin_amdgcn_update_dpp(0, __float_as_int(v), 0x121, 0xF, 0xF, false)); }
__device__ __forceinline__ float dpp_ror15(float v) { return __int_as_float(__builtin_amdgcn_update_dpp(0, __float_as_int(v), 0x12F, 0xF, 0xF, false)); }
constexpr int LDS_EX = 131072 + 256;
struct EpiUpConv {
    bf16_t* ACT; const float* cw; const float* cb;
    __device__ __forceinline__ void operator()(AccT& acc, const Unit& u, int brow, int bcol, int wr, int wc, int fr, int fq) const {
        extern __shared__ __attribute__((aligned(16))) unsigned char smem[];
        float* EX = (float*)(smem + LDS_EX);
        const bool sp = u.sp != 0;
        const bool lat = !sp && u.pm >= 16;
        const bool first = lat && (((u.pm - 16) & 15) == 0);
#pragma unroll
        for (int ai = 0; ai < 2; ++ai) {
#pragma unroll
            for (int m = 0; m < 4; ++m) {
                const int rl = ai * 128 + wr * 64 + m * 16 + fr;
                if (sp ? ((rl & 63) >= 33) : (first && rl == 0)) { acc[ai][0][m][0] = (f32x4){0.f, 0.f, 0.f, 0.f}; acc[ai][0][m][1] = (f32x4){0.f, 0.f, 0.f, 0.f}; }
            }
            const int sidx = ai * 2 + wr;
            if (fr == 0) {
#pragma unroll
                for (int n = 0; n < 2; ++n) *(f32x4*)(EX + ((0 * 4 + sidx) * 4 + wc) * 32 + n * 16 + fq * 4) = acc[ai][0][0][n];
            }
            if (fr == 15) {
#pragma unroll
                for (int n = 0; n < 2; ++n) *(f32x4*)(EX + ((1 * 4 + sidx) * 4 + wc) * 32 + n * 16 + fq * 4) = acc[ai][0][3][n];
            }
        }
        __syncthreads();
        const int f0 = (bcol >> 1) + wc * 32 + fq * 4;
#pragma unroll
        for (int n = 0; n < 2; ++n) {
            const int f = f0 + n * 16;
            const f32x4 w0 = *(const f32x4*)(cw + f), w1 = *(const f32x4*)(cw + DFF + f), w2 = *(const f32x4*)(cw + 2 * DFF + f), bb = *(const f32x4*)(cb + f);
#pragma unroll
            for (int ai = 0; ai < 2; ++ai) {
                const int sidx = ai * 2 + wr;
                f32x4 exp_ = (f32x4){0.f, 0.f, 0.f, 0.f}, exn = (f32x4){0.f, 0.f, 0.f, 0.f};
                if (sidx > 0) exp_ = *(const f32x4*)(EX + ((1 * 4 + sidx - 1) * 4 + wc) * 32 + n * 16 + fq * 4);
                if (sidx < 3) exn = *(const f32x4*)(EX + ((0 * 4 + sidx + 1) * 4 + wc) * 32 + n * 16 + fq * 4);
#pragma unroll
                for (int m = 0; m < 4; ++m) {
                    const int rl = ai * 128 + wr * 64 + m * 16 + fr;
                    const f32x4 cur = acc[ai][0][m][n];
                    f32x4 pv, nx;
#pragma unroll
                    for (int j = 0; j < 4; ++j) {
                        const float pw = m > 0 ? dpp_ror1(acc[ai][0][m > 0 ? m - 1 : 0][n][j]) : exp_[j];
                        pv[j] = __int_as_float(__builtin_amdgcn_update_dpp(__float_as_int(pw), __float_as_int(cur[j]), 0x111, 0xF, 0xF, false));
                        const float nw = m < 3 ? dpp_ror15(acc[ai][0][m < 3 ? m + 1 : 3][n][j]) : exn[j];
                        nx[j] = __int_as_float(__builtin_amdgcn_update_dpp(__float_as_int(nw), __float_as_int(cur[j]), 0x101, 0xF, 0xF, false));
                    }
                    const f32x4 c = w0 * pv + w1 * cur + w2 * nx + bb;
                    const f32x4 vv = acc[ai][1][m][n];
                    u32x2 o; o.x = pk2(siluf(c[0]) * vv[0], siluf(c[1]) * vv[1]); o.y = pk2(siluf(c[2]) * vv[2], siluf(c[3]) * vv[3]);
                    const int jj = rl & 63;
                    const bool wr_ok = sp ? (jj >= 1 && jj < 33) : (!lat || (rl != 0 && rl != 255));
                    const int orow = sp ? brow + (rl >> 6) * 4096 + jj : brow + rl;
                    if (wr_ok) *(u32x2*)(ACT + (size_t)orow * DFF + f) = o;
                }
            }
        }
    }
};

#ifndef GSEL
#define GSEL -1
#endif
template <int ID, class Epi>
__device__ __forceinline__ void run_gemm(const bf16_t* A, int lda, const bf16_t* Bt, int K, int N, int row0, int nrows, const Epi& epi, int ksplit = 1) {
    if (!EN_GEMM) return;
    if (GSEL >= 0 && ID != GSEL) return;
    Gemm g{A, Bt, lda, K, K / ksplit};
    Order S{row0 / BM, nrows / BM, N / BM, (nrows / BM) * (N / BM), (int)gridDim.x, (int)blockIdx.x, 0, ksplit};
    gemm_phase<false>(g, S, epi);
}
template <class Epi>
__device__ __forceinline__ void run_gemm_n128(const bf16_t* A, int lda, const bf16_t* Bt, int K, int N, const Epi& epi) {
    if (!EN_GEMM) return;
    Gemm g{A, Bt, lda, K, K};
    Order S{0, NTOK / BM, N / HALF, (NTOK / BM) * (N / HALF), (int)gridDim.x, (int)blockIdx.x, 0, 1};
    gemm_phase_n128(g, S, epi);
}
template <class Epi>
__device__ __forceinline__ void run_gemm_up(const bf16_t* A, const bf16_t* Bt, const Epi& epi) {
    if (!EN_GEMM) return;
    Gemm g{A, Bt, DM, DM, DM};
    Order S{0, 81, 22, 81 * 22, (int)gridDim.x, (int)blockIdx.x, 1, 1};
    gemm_phase<true>(g, S, epi);
}

struct AttnUnit {
    const bf16_t* Q; int qs;
    const bf16_t *K1, *V1; int s1, n1;
    const bf16_t *K2, *V2; int s2, n2;
    bf16_t* O; int os;
    int kind, r0, rb0; const float* rpb;
    const float* gq; const float* gk; const unsigned* kmax; int kw;
};
__device__ __forceinline__ int swz8(int row) { return (((row >> 1) & 1) << 2) | (((row >> 2) & 1) << 1) | ((row >> 3) & 1); }
__device__ __forceinline__ s16x4 vtr(const unsigned char* p) { return __builtin_bit_cast(s16x4, __builtin_amdgcn_ds_read_tr16_b64_v4i16((LAS s16x4*)p)); }

__device__ __forceinline__ void attn_unit_old(const AttnUnit& u) {
    extern __shared__ __attribute__((aligned(16))) unsigned char smem[];
    const int tid = otid(), w = tid >> 6, lane = tid & 63, r32 = lane & 31, hh = lane >> 5;
    float* rpbs = (float*)(smem + 32768);
    __syncthreads();
    if (u.kind == 1) { for (int i = tid; i < 465; i += NTHREADS) rpbs[i] = u.rpb[i] * 1.4426950408889634f; }
    bf16x8 qf[4];
    {
        const bf16_t* qp = u.Q + (size_t)(32 * w + r32) * u.qs + 8 * hh;
#pragma unroll
        for (int ks = 0; ks < 4; ++ks) qf[ks] = *(const bf16x8*)(qp + 16 * ks);
    }
    f32x16 o0, o1;
#pragma unroll
    for (int i = 0; i < 16; ++i) { o0[i] = 0.f; o1[i] = 0.f; }
    float mrun = -1e30f, lsum = 0.f;
    const int nt = u.n1 + u.n2;
    const int srow = tid >> 3, sch = tid & 7;
    const int soff = srow * 128 + ((sch ^ swz8(srow)) << 4);
    u32x4 kreg, vreg;
    {
        const bf16_t* kp = u.n1 > 0 ? u.K1 : u.K2; const bf16_t* vp = u.n1 > 0 ? u.V1 : u.V2; const int st = u.n1 > 0 ? u.s1 : u.s2;
        kreg = *(const u32x4*)(kp + (size_t)srow * st + sch * 8); vreg = *(const u32x4*)(vp + (size_t)srow * st + sch * 8);
    }
    const float SC = 0.125f * 1.4426950408889634f;
    const int qrow = u.r0 + (w >> 1), qc = (w & 1) * 32 + r32;
    const int rs = min(max(qrow - 4, 0), 56), cs = min(max(qc - 8, 0), 48);
    for (int ti = 0; ti < nt; ++ti) {
        unsigned char* kb_ = smem + (ti & 1) * 16384;
        unsigned char* vb_ = kb_ + 8192;
        *(u32x4*)(kb_ + soff) = kreg; *(u32x4*)(vb_ + soff) = vreg;
        __syncthreads();
        if (ti + 1 < nt) {
            const int tn = ti + 1;
            const bf16_t* kp; const bf16_t* vp; int st;
            if (tn < u.n1) { kp = u.K1 + (size_t)tn * 64 * u.s1; vp = u.V1 + (size_t)tn * 64 * u.s1; st = u.s1; }
            else { kp = u.K2 + (size_t)(tn - u.n1) * 64 * u.s2; vp = u.V2 + (size_t)(tn - u.n1) * 64 * u.s2; st = u.s2; }
            kreg = *(const u32x4*)(kp + (size_t)srow * st + sch * 8); vreg = *(const u32x4*)(vp + (size_t)srow * st + sch * 8);
        }
        const bool local = (u.kind == 1) && (ti < u.n1);
        int dr = 0;
        if (local) { const int kr = u.rb0 + ti; if (kr < rs || kr >= rs + 8) continue; dr = kr - qrow + 7; }
        f32x16 st0, st1;
#pragma unroll
        for (int i = 0; i < 16; ++i) { st0[i] = 0.f; st1[i] = 0.f; }
#pragma unroll
        for (int ks = 0; ks < 4; ++ks) {
            const int ch = 2 * ks + hh;
            const int ra = r32, rb = 32 + r32;
            const bf16x8 ka = *(const bf16x8*)(kb_ + ra * 128 + ((ch ^ swz8(ra)) << 4));
            const bf16x8 kb2 = *(const bf16x8*)(kb_ + rb * 128 + ((ch ^ swz8(rb)) << 4));
            st0 = __builtin_amdgcn_mfma_f32_32x32x16_bf16(ka, qf[ks], st0, 0, 0, 0);
            st1 = __builtin_amdgcn_mfma_f32_32x32x16_bf16(kb2, qf[ks], st1, 0, 0, 0);
        }
        float tmax = -1e30f;
        if (local) {
            const float* rp = rpbs + dr * 31;
#pragma unroll
            for (int i = 0; i < 16; ++i) {
                const int kc0 = (i & 3) + 8 * (i >> 2) + 4 * hh, kc1 = kc0 + 32;
                const bool v0 = (kc0 >= cs) && (kc0 < cs + 16), v1 = (kc1 >= cs) && (kc1 < cs + 16);
                const float b0 = rp[v0 ? kc0 - qc + 15 : 0], b1 = rp[v1 ? kc1 - qc + 15 : 0];
                st0[i] = v0 ? st0[i] + b0 : -1e30f;
                st1[i] = v1 ? st1[i] + b1 : -1e30f;
            }
        }
#pragma unroll
        for (int i = 0; i < 16; ++i) tmax = fmaxf(tmax, fmaxf(st0[i], st1[i]));
        tmax = fmaxf(tmax, __shfl_xor(tmax, 32));
        const float mnew = fmaxf(mrun, tmax);
        const float alpha = __builtin_amdgcn_exp2f(mrun - mnew);
        mrun = mnew;
        float ps = 0.f;
#pragma unroll
        for (int i = 0; i < 16; ++i) { st0[i] = __builtin_amdgcn_exp2f(st0[i] - mnew); st1[i] = __builtin_amdgcn_exp2f(st1[i] - mnew); ps += st0[i] + st1[i]; }
        lsum = lsum * alpha + ps;
#pragma unroll
        for (int i = 0; i < 16; ++i) { o0[i] *= alpha; o1[i] *= alpha; }
#pragma unroll
        for (int kb = 0; kb < 2; ++kb)
#pragma unroll
            for (int s = 0; s < 2; ++s) {
                u32x4 pw;
                if (kb == 0) { pw.x = pk2(st0[8 * s + 0], st0[8 * s + 1]); pw.y = pk2(st0[8 * s + 2], st0[8 * s + 3]); pw.z = pk2(st0[8 * s + 4], st0[8 * s + 5]); pw.w = pk2(st0[8 * s + 6], st0[8 * s + 7]); }
                else { pw.x = pk2(st1[8 * s + 0], st1[8 * s + 1]); pw.y = pk2(st1[8 * s + 2], st1[8 * s + 3]); pw.z = pk2(st1[8 * s + 4], st1[8 * s + 5]); pw.w = pk2(st1[8 * s + 6], st1[8 * s + 7]); }
                const bf16x8 pf = __builtin_bit_cast(bf16x8, pw);
                const int kbase = kb * 32 + 16 * s + 4 * hh;
                const int q = (lane & 15) >> 2, p4 = lane & 3, gsel = (lane >> 4) & 1;
#pragma unroll
                for (int db = 0; db < 2; ++db) {
                    const int dcol = db * 32 + 16 * gsel + 4 * p4;
                    const int r1 = kbase + q, r2 = kbase + 8 + q;
                    const s16x4 a1 = vtr(vb_ + r1 * 128 + (((dcol >> 3) ^ swz8(r1)) << 4) + (dcol & 7) * 2);
                    const s16x4 a2 = vtr(vb_ + r2 * 128 + (((dcol >> 3) ^ swz8(r2)) << 4) + (dcol & 7) * 2);
                    bf16x8 vf; vf[0] = a1[0]; vf[1] = a1[1]; vf[2] = a1[2]; vf[3] = a1[3]; vf[4] = a2[0]; vf[5] = a2[1]; vf[6] = a2[2]; vf[7] = a2[3];
                    if (db == 0) o0 = __builtin_amdgcn_mfma_f32_32x32x16_bf16(vf, pf, o0, 0, 0, 0);
                    else o1 = __builtin_amdgcn_mfma_f32_32x32x16_bf16(vf, pf, o1, 0, 0, 0);
                }
            }
    }
    lsum += __shfl_xor(lsum, 32);
    const float inv = 1.0f / lsum;
    bf16_t* op = u.O + (size_t)(32 * w + r32) * u.os;
#pragma unroll
    for (int rg = 0; rg < 4; ++rg) {
        u32x2 w0, w1;
        w0.x = pk2(o0[4 * rg] * inv, o0[4 * rg + 1] * inv); w0.y = pk2(o0[4 * rg + 2] * inv, o0[4 * rg + 3] * inv);
        w1.x = pk2(o1[4 * rg] * inv, o1[4 * rg + 1] * inv); w1.y = pk2(o1[4 * rg + 2] * inv, o1[4 * rg + 3] * inv);
        *(u32x2*)(op + 8 * rg + 4 * hh) = w0;
        *(u32x2*)(op + 32 + 8 * rg + 4 * hh) = w1;
    }
}

template <bool NA>
__device__ __forceinline__ void attn_unit64(const AttnUnit& u) {
    extern __shared__ __attribute__((aligned(16))) unsigned char smem[];
    const int tid = otid(), w = tid >> 6, lane = tid & 63, r32 = lane & 31, hh = lane >> 5;
    float* rpbs = (float*)(smem + 32768);
    __syncthreads();
    if (NA) { for (int i = tid; i < 465; i += NTHREADS) rpbs[i] = u.rpb[i] * 1.4426950408889634f; }
    const int qrow = u.r0 + w;
    const int rs = min(max(qrow - 4, 0), 56);
    bf16x8 qf[2][4];
#pragma unroll
    for (int qb = 0; qb < 2; ++qb) {
        const bf16_t* qp = u.Q + (size_t)(64 * w + 32 * qb + r32) * u.qs + 8 * hh;
#pragma unroll
        for (int ks = 0; ks < 4; ++ks) qf[qb][ks] = *(const bf16x8*)(qp + 16 * ks);
    }
    f32x16 o[2][2];
#pragma unroll
    for (int qb = 0; qb < 2; ++qb)
#pragma unroll
        for (int db = 0; db < 2; ++db)
#pragma unroll
            for (int i = 0; i < 16; ++i) o[qb][db][i] = 0.f;
    float lsum[2] = {0.f, 0.f};
    float nmS;
    {
        float g1 = fabsf(u.gq[lane]), g2 = fabsf(u.gk[lane]);
#pragma unroll
        for (int o_ = 32; o_ >= 1; o_ >>= 1) { g1 = fmaxf(g1, __shfl_xor(g1, o_)); g2 = fmaxf(g2, __shfl_xor(g2, o_)); }
        const float kc = sqrtf(__uint_as_float(u.kmax[u.kw]));
        const float mk = fmaxf(8.0f * g2, kc) * 1.01f, mq = 8.0f * g1 * 1.01f;
        nmS = -(QSC * mq * mk + (NA ? __uint_as_float(u.kmax[2]) * 1.4426950408889634f : 0.f));
    }
    if (-nmS > 100.0f) {
        AttnUnit v = u; attn_unit_old(v);
        v.Q += (size_t)256 * u.qs; v.O += (size_t)256 * u.os; v.r0 += 4; attn_unit_old(v);
        return;
    }
    const int nt = u.n1 + u.n2;
    const int srow = tid >> 3, sch = (tid & 7) ^ swz8(tid >> 3);
    LAS unsigned char* ldsb = (LAS unsigned char*)smem;
#define A64_DMA(tn, bufoff) do { const bf16_t* kp_; const bf16_t* vp_; int st_; \
        if ((tn) < u.n1) { kp_ = u.K1 + (size_t)(tn) * 64 * u.s1; vp_ = u.V1 + (size_t)(tn) * 64 * u.s1; st_ = u.s1; } \
        else { kp_ = u.K2 + (size_t)((tn) - u.n1) * 64 * u.s2; vp_ = u.V2 + (size_t)((tn) - u.n1) * 64 * u.s2; st_ = u.s2; } \
        __builtin_amdgcn_global_load_lds((const unsigned*)(kp_ + (size_t)srow * st_ + sch * 8), (LAS unsigned*)(ldsb + (bufoff) + tid * 16), 16, 0, 0); \
        __builtin_amdgcn_global_load_lds((const unsigned*)(vp_ + (size_t)srow * st_ + sch * 8), (LAS unsigned*)(ldsb + (bufoff) + 8192 + tid * 16), 16, 0, 0); } while (0)
    A64_DMA(0, 0);
    const float SC = 0.125f * 1.4426950408889634f;
    const int q4 = (lane & 15) >> 2, p4 = lane & 3, gsel = (lane >> 4) & 1;
    if (__builtin_amdgcn_readfirstlane(tid) >= 256) __builtin_amdgcn_s_setprio(1);
    for (int ti = 0; ti < nt; ++ti) {
        unsigned char* kb_ = smem + (ti & 1) * 16384;
        unsigned char* vb_ = kb_ + 8192;
        asm volatile("s_waitcnt vmcnt(0)" ::: "memory");
        __syncthreads();
        if (ti + 1 < nt) A64_DMA(ti + 1, ((ti + 1) & 1) * 16384);
        const bool local = NA && (ti < u.n1);
        if (local) { const int kr = u.rb0 + ti; if (kr < rs || kr >= rs + 8) continue; }
        f32x16 st_[2][2];
#pragma unroll
        for (int qb = 0; qb < 2; ++qb)
#pragma unroll
            for (int kb = 0; kb < 2; ++kb)
#pragma unroll
                for (int i = 0; i < 16; ++i) st_[qb][kb][i] = 0.f;
#pragma unroll
        for (int ks = 0; ks < 4; ++ks) {
            const int ch = 2 * ks + hh;
            const int ra = r32, rb = 32 + r32;
            const bf16x8 ka = *(const bf16x8*)(kb_ + ra * 128 + ((ch ^ swz8(ra)) << 4));
            const bf16x8 kb2 = *(const bf16x8*)(kb_ + rb * 128 + ((ch ^ swz8(rb)) << 4));
#pragma unroll
            for (int qb = 0; qb < 2; ++qb) {
                st_[qb][0] = __builtin_amdgcn_mfma_f32_32x32x16_bf16(ka, qf[qb][ks], st_[qb][0], 0, 0, 0);
                st_[qb][1] = __builtin_amdgcn_mfma_f32_32x32x16_bf16(kb2, qf[qb][ks], st_[qb][1], 0, 0, 0);
            }
        }
        bf16x8 pfs[2][4];
#pragma unroll
        for (int qb = 0; qb < 2; ++qb) {
            if (local) {
                const float* rp = rpbs + (u.rb0 + ti - qrow + 7) * 31;
                const int qc = 32 * qb + r32, cs = min(max(qc - 8, 0), 48);
#pragma unroll
                for (int i = 0; i < 16; ++i) {
                    const int kc0 = (i & 3) + 8 * (i >> 2) + 4 * hh, kc1 = kc0 + 32;
                    const bool v0 = (kc0 >= cs) && (kc0 < cs + 16), v1 = (kc1 >= cs) && (kc1 < cs + 16);
                    const float b0 = rp[v0 ? kc0 - qc + 15 : 0], b1 = rp[v1 ? kc1 - qc + 15 : 0];
                    st_[qb][0][i] = v0 ? st_[qb][0][i] + b0 : -1e30f;
                    st_[qb][1][i] = v1 ? st_[qb][1][i] + b1 : -1e30f;
                }
            }
            float ps = 0.f;
#pragma unroll
            for (int i = 0; i < 16; ++i) {
                st_[qb][0][i] = __builtin_amdgcn_exp2f(st_[qb][0][i]);
                st_[qb][1][i] = __builtin_amdgcn_exp2f(st_[qb][1][i]);
                ps += st_[qb][0][i] + st_[qb][1][i];
            }
            lsum[qb] += ps;
#pragma unroll
            for (int kb = 0; kb < 2; ++kb)
#pragma unroll
                for (int s2 = 0; s2 < 2; ++s2) {
                    u32x4 pw;
                    pw.x = pk2(st_[qb][kb][8 * s2 + 0], st_[qb][kb][8 * s2 + 1]); pw.y = pk2(st_[qb][kb][8 * s2 + 2], st_[qb][kb][8 * s2 + 3]);
                    pw.z = pk2(st_[qb][kb][8 * s2 + 4], st_[qb][kb][8 * s2 + 5]); pw.w = pk2(st_[qb][kb][8 * s2 + 6], st_[qb][kb][8 * s2 + 7]);
                    pfs[qb][kb * 2 + s2] = __builtin_bit_cast(bf16x8, pw);
                }
        }
#pragma unroll
        for (int kb = 0; kb < 2; ++kb)
#pragma unroll
            for (int s2 = 0; s2 < 2; ++s2) {
                const int kbase = kb * 32 + 16 * s2 + 4 * hh;
#pragma unroll
                for (int db = 0; db < 2; ++db) {
                    const int dcol = db * 32 + 16 * gsel + 4 * p4;
                    const int r1 = kbase + q4, r2 = kbase + 8 + q4;
                    const s16x4 a1 = vtr(vb_ + r1 * 128 + (((dcol >> 3) ^ swz8(r1)) << 4) + (dcol & 7) * 2);
                    const s16x4 a2 = vtr(vb_ + r2 * 128 + (((dcol >> 3) ^ swz8(r2)) << 4) + (dcol & 7) * 2);
                    bf16x8 vf; vf[0] = a1[0]; vf[1] = a1[1]; vf[2] = a1[2]; vf[3] = a1[3]; vf[4] = a2[0]; vf[5] = a2[1]; vf[6] = a2[2]; vf[7] = a2[3];
#pragma unroll
                    for (int qb = 0; qb < 2; ++qb) o[qb][db] = __builtin_amdgcn_mfma_f32_32x32x16_bf16(vf, pfs[qb][kb * 2 + s2], o[qb][db], 0, 0, 0);
                }
            }
    }
#undef A64_DMA
    __builtin_amdgcn_s_setprio(0);
#pragma unroll
    for (int qb = 0; qb < 2; ++qb) {
        float l = lsum[qb]; l += __shfl_xor(l, 32);
        const float inv = 1.0f / l;
        bf16_t* op = u.O + (size_t)(64 * w + 32 * qb + r32) * u.os;
#pragma unroll
        for (int rg = 0; rg < 4; ++rg) {
            u32x2 w0, w1;
            w0.x = pk2(o[qb][0][4 * rg] * inv, o[qb][0][4 * rg + 1] * inv); w0.y = pk2(o[qb][0][4 * rg + 2] * inv, o[qb][0][4 * rg + 3] * inv);
            w1.x = pk2(o[qb][1][4 * rg] * inv, o[qb][1][4 * rg + 1] * inv); w1.y = pk2(o[qb][1][4 * rg + 2] * inv, o[qb][1][4 * rg + 3] * inv);
            *(u32x2*)(op + 8 * rg + 4 * hh) = w0;
            *(u32x2*)(op + 32 + 8 * rg + 4 * hh) = w1;
        }
    }
}

template <bool PASS2>
__device__ __forceinline__ void ssm_task(const Params& P, int task) {
    extern __shared__ __attribute__((aligned(16))) unsigned char smem[];
    unsigned char* ws = P.ws;
    const int tid = otid(), w = tid >> 6, lane = tid & 63, n = lane & 31, hh = lane >> 5;
    const int pj = task >> 2, g = (task & 3) * 8 + w;
    const bf16_t* U = (const bf16_t*)(ws + WS_U);
    const float* ENDr = (const float*)(ws + WS_END);
    float* ENDw = (float*)(ws + WS_END);
    unsigned char* himg = smem + w * 8192;
    const int c_l = 2 * pj + hh;
    int kidx_l, nch, seqb; bool ctx;
    if (c_l < 64) { ctx = true; kidx_l = c_l & 3; nch = 4; seqb = c_l >> 2; }
    else { ctx = false; kidx_l = (c_l - 64) & 63; nch = 64; seqb = (c_l - 64) >> 6; }
    const int cs0 = c_l - kidx_l;
    const int kidx0 = kidx_l - hh;
    f32x4 yacc[2][4];
#pragma unroll
    for (int a = 0; a < 2; ++a)
#pragma unroll
        for (int b = 0; b < 4; ++b) yacc[a][b] = (f32x4){0.f, 0.f, 0.f, 0.f};

#pragma unroll 1
    for (int dir = 0; dir < 2; ++dir) {
        const int dg = dir * 32 + g;
        bf16x8 bmf[2][2];
#pragma unroll
        for (int comp = 0; comp < 2; ++comp)
#pragma unroll
            for (int sh = 0; sh < 2; ++sh) bmf[comp][sh] = *(const bf16x8*)((const bf16_t*)(ws + WS_BM) + ((size_t)((dg * 2 + comp) * 64 + sh * 32 + n)) * 16 + 8 * hh);
        bf16x8 cmf[4];
        if (PASS2) {
#pragma unroll
            for (int ks = 0; ks < 4; ++ks) cmf[ks] = *(const bf16x8*)((const bf16_t*)(ws + WS_CM) + ((size_t)(dg * 16 + (lane & 15))) * 128 + 32 * ks + 8 * (lane >> 4));
        }
        float ar[2], ai[2], hr[2], hi[2];
#pragma unroll
        for (int sh = 0; sh < 2; ++sh) {
            const f32x2 a = *(const f32x2*)((const float*)(ws + WS_SSA) + ((size_t)(dg * 64 + sh * 32 + n)) * 2);
            ar[sh] = a.x; ai[sh] = a.y; hr[sh] = 0.f; hi[sh] = 0.f;
        }
        if (PASS2) {
            const float* e = ENDr + ((size_t)((c_l * 2 + dir) * 32 + g)) * 128;
#pragma unroll
            for (int sh = 0; sh < 2; ++sh) { hr[sh] = e[sh * 32 + n]; hi[sh] = e[64 + sh * 32 + n]; }
        }
#pragma unroll 1
        for (int bb = 0; bb < 4; ++bb) {
            const int blk = dir == 0 ? bb : 3 - bb;
            const int m_ = lane & 31;
            const int arow = 64 * (2 * pj + ((m_ >> 2) & 1)) + 16 * blk + (m_ & 3) + 4 * (m_ >> 3);
            const bf16x8 af = *(const bf16x8*)(U + (size_t)arow * 512 + 16 * g + 8 * hh);
            f32x16 bu[2][2];
#pragma unroll
            for (int comp = 0; comp < 2; ++comp)
#pragma unroll
                for (int sh = 0; sh < 2; ++sh) {
                    f32x16 z;
#pragma unroll
                    for (int i = 0; i < 16; ++i) z[i] = 0.f;
                    bu[comp][sh] = __builtin_amdgcn_mfma_f32_32x32x16_bf16(af, bmf[comp][sh], z, 0, 0, 0);
                }
#pragma unroll
            for (int sh = 0; sh < 2; ++sh) {
                float cr = hr[sh], ci = hi[sh];
                const float a_r = ar[sh], a_i = ai[sh];
#pragma unroll
                for (int ii = 0; ii < 16; ++ii) {
                    const int i = dir == 0 ? ii : 15 - ii;
                    const float nr = a_r * cr - a_i * ci + bu[0][sh][i];
                    const float ni = a_r * ci + a_i * cr + bu[1][sh][i];
                    cr = nr; ci = ni; bu[0][sh][i] = cr; bu[1][sh][i] = ci;
                }
                hr[sh] = cr; hi[sh] = ci;
            }
            if (PASS2) {
                asm volatile("s_waitcnt lgkmcnt(0)" ::: "memory");
#pragma unroll
                for (int comp = 0; comp < 2; ++comp)
#pragma unroll
                    for (int sh = 0; sh < 2; ++sh) {
                        u32x4 w0, w1;
                        w0.x = pk2(bu[comp][sh][0], bu[comp][sh][1]); w0.y = pk2(bu[comp][sh][2], bu[comp][sh][3]); w0.z = pk2(bu[comp][sh][4], bu[comp][sh][5]); w0.w = pk2(bu[comp][sh][6], bu[comp][sh][7]);
                        w1.x = pk2(bu[comp][sh][8], bu[comp][sh][9]); w1.y = pk2(bu[comp][sh][10], bu[comp][sh][11]); w1.z = pk2(bu[comp][sh][12], bu[comp][sh][13]); w1.w = pk2(bu[comp][sh][14], bu[comp][sh][15]);
                        unsigned char* hp = himg + (comp * 64 + sh * 32 + n) * 64 + hh * 32;
                        *(u32x4*)hp = w0; *(u32x4*)(hp + 16) = w1;
                    }
                asm volatile("s_waitcnt lgkmcnt(0)" ::: "memory");
                const int gq = lane >> 4, li = lane & 15, q = li >> 2, p4 = li & 3;
#pragma unroll
                for (int tt = 0; tt < 2; ++tt)
#pragma unroll
                    for (int ks = 0; ks < 4; ++ks) {
                        const unsigned char* hp = himg + (32 * ks + 8 * gq + q) * 64 + (16 * tt + 4 * p4) * 2;
                        const s16x4 a1 = vtr(hp), a2 = vtr(hp + 4 * 64);
                        bf16x8 hf; hf[0] = a1[0]; hf[1] = a1[1]; hf[2] = a1[2]; hf[3] = a1[3]; hf[4] = a2[0]; hf[5] = a2[1]; hf[6] = a2[2]; hf[7] = a2[3];
                        yacc[tt][blk] = __builtin_amdgcn_mfma_f32_16x16x32_bf16(cmf[ks], hf, yacc[tt][blk], 0, 0, 0);
                    }
            }
        }
        if (!PASS2) {
            float* e = ENDw + ((size_t)((c_l * 2 + dir) * 32 + g)) * 128;
#pragma unroll
            for (int sh = 0; sh < 2; ++sh) { e[sh * 32 + n] = hr[sh]; e[64 + sh * 32 + n] = hi[sh]; }
        } else if (ctx && ((dir == 0 && kidx_l == 3) || (dir == 1 && kidx_l == 0))) {
            const size_t si = ((size_t)((seqb * 2 + dir) * 32 + g)) * 64;
#pragma unroll
            for (int sh = 0; sh < 2; ++sh) { P.out[O_SRE + si + sh * 32 + n] = hr[sh]; P.out[O_SIM + si + sh * 32 + n] = hi[sh]; }
        }
    }
    if (PASS2) {
        bf16_t* YG = (bf16_t*)(ws + WS_YG);
        const int c4 = 4 * (lane >> 4);
        const f32x4 dd = *(const f32x4*)(P.in[30] + g * 16 + c4);
#pragma unroll
        for (int tt = 0; tt < 2; ++tt)
#pragma unroll
            for (int blk = 0; blk < 4; ++blk) {
                const int tok = 64 * (2 * pj + tt) + 16 * blk + (lane & 15);
                const u32x2 uw = *(const u32x2*)(U + (size_t)tok * 512 + 16 * g + c4);
                const float y0 = gelu_tanh(yacc[tt][blk][0] + dd[0] * bflo(uw.x)), y1 = gelu_tanh(yacc[tt][blk][1] + dd[1] * bfhi(uw.x));
                const float y2 = gelu_tanh(yacc[tt][blk][2] + dd[2] * bflo(uw.y)), y3 = gelu_tanh(yacc[tt][blk][3] + dd[3] * bfhi(uw.y));
                u32x2 o; o.x = pk2(y0, y1); o.y = pk2(y2, y3);
                *(u32x2*)(YG + (size_t)tok * 512 + 16 * g + c4) = o;
            }
    }
}

__device__ __forceinline__ void carry_phase(const Params& P) {
    unsigned char* ws = P.ws;
    float* END = (float*)(ws + WS_END);
    const int x = blockIdx.x * NTHREADS + otid();
    if (x >= 16384 + 65536) return;
    int seq, dir, g, p, nch, cs0; bool lat;
    if (x < 16384) { lat = true; seq = x >> 12; dir = (x >> 11) & 1; g = (x >> 6) & 31; p = x & 63; nch = 64; cs0 = 64 + seq * 64; }
    else { const int y = x - 16384; lat = false; seq = y >> 12; dir = (y >> 11) & 1; g = (y >> 6) & 31; p = y & 63; nch = 4; cs0 = seq * 4; }
    const int dg = dir * 32 + g;
    const f32x2 a64 = *(const f32x2*)((const float*)(ws + WS_SSA64) + ((size_t)(dg * 64 + p)) * 2);
    float cr = 0.f, ci = 0.f;
    if (lat) { const size_t si = ((size_t)((seq * 2 + dir) * 32 + g)) * 64 + p; cr = P.in[4][si]; ci = P.in[5][si]; }
    for (int k0 = 0; k0 < nch; k0 += 16) {
        float er[16], ei[16]; float* ep[16];
#pragma unroll
        for (int q = 0; q < 16; ++q) {
            const int k = min(k0 + q, nch - 1), ck = dir == 0 ? cs0 + k : cs0 + nch - 1 - k;
            ep[q] = END + ((size_t)((ck * 2 + dir) * 32 + g)) * 128 + p;
            er[q] = ep[q][0]; ei[q] = ep[q][64];
        }
#pragma unroll
        for (int q = 0; q < 16; ++q) {
            if (k0 + q < nch) {
                ep[q][0] = cr; ep[q][64] = ci;
                const float nr = a64.x * cr - a64.y * ci + er[q], ni = a64.x * ci + a64.y * cr + ei[q];
                cr = nr; ci = ni;
            }
        }
    }
}

struct WDesc { const float* src; bf16_t* dst; int K, N, tiles; };

template <bool UPPERM>
__device__ __forceinline__ void prep_wtile(const float* W, bf16_t* Wt, int K, int N, int tile) {
    extern __shared__ __attribute__((aligned(16))) unsigned char smem[];
    float* T = (float*)smem;
    const int nN = N / 256, tk = tile / nN, tn = tile % nN, k0 = tk * 64, n0 = tn * 256, tid = otid();
    __syncthreads();
    f32x4 v[8];
#pragma unroll
    for (int i = 0; i < 8; ++i) { const int idx = tid + 512 * i, k = idx >> 6, n4 = idx & 63; v[i] = *(const f32x4*)(W + (size_t)(k0 + k) * N + n0 + n4 * 4); }
#pragma unroll
    for (int i = 0; i < 8; ++i) { const int idx = tid + 512 * i, k = idx >> 6, n4 = idx & 63; float* t = T + k * 257 + n4 * 4; t[0] = v[i][0]; t[1] = v[i][1]; t[2] = v[i][2]; t[3] = v[i][3]; }
    __syncthreads();
#pragma unroll
    for (int i = 0; i < 4; ++i) {
        const int cidx = tid + 512 * i, nn = cidx >> 3, kc = cidx & 7;
        const int c = n0 + nn;
        int pos;
        if (UPPERM) { const int bjj = c >= DFF ? 1 : 0, f = c - bjj * DFF; pos = (f >> 7) * 256 + bjj * 128 + (f & 127); }
        else pos = (c & ~255) | (((c >> 5) & 1) << 7) | (((c >> 6) & 3) << 5) | (c & 31);
        const float* t = T + (kc * 8) * 257 + nn;
        u32x4 o;
        o.x = pk2(t[0], t[257]); o.y = pk2(t[2 * 257], t[3 * 257]); o.z = pk2(t[4 * 257], t[5 * 257]); o.w = pk2(t[6 * 257], t[7 * 257]);
        *(u32x4*)(Wt + (size_t)pos * K + k0 + kc * 8) = o;
    }
}

__device__ __forceinline__ void prep_mod(const Params& P, int task) {
    extern __shared__ __attribute__((aligned(16))) unsigned char smem[];
    float* S = (float*)smem;
    float* PS = S + 5 * 1024;
    const int l = task / 96, cb = task % 96, tid = otid();
    __syncthreads();
    for (int i = tid; i < 5 * 1024; i += NTHREADS) {
        const int j = i >> 10, k = i & 1023;
        const float v = j == 0 ? P.in[9][k] : P.in[8][(j - 1) * 1024 + k];
        S[i] = siluf(v);
    }
    __syncthreads();
    const int ks = tid >> 6, col = tid & 63;
    const float* W = P.in[12] + (size_t)l * 1024 * 6144 + cb * 64 + col;
    float a0 = 0, a1 = 0, a2 = 0, a3 = 0, a4 = 0;
    for (int k0 = ks * 128; k0 < ks * 128 + 128; k0 += 32) {
        float wv[32];
#pragma unroll
        for (int i = 0; i < 32; ++i) wv[i] = W[(size_t)(k0 + i) * 6144];
#pragma unroll
        for (int i = 0; i < 32; ++i) { const int k = k0 + i; a0 += S[k] * wv[i]; a1 += S[1024 + k] * wv[i]; a2 += S[2048 + k] * wv[i]; a3 += S[3072 + k] * wv[i]; a4 += S[4096 + k] * wv[i]; }
    }
    PS[(ks * 5 + 0) * 64 + col] = a0; PS[(ks * 5 + 1) * 64 + col] = a1; PS[(ks * 5 + 2) * 64 + col] = a2; PS[(ks * 5 + 3) * 64 + col] = a3; PS[(ks * 5 + 4) * 64 + col] = a4;
    __syncthreads();
    if (tid < 320) {
        const int j = tid >> 6, c = tid & 63;
        float s = P.in[13][l * 6144 + cb * 64 + c];
#pragma unroll
        for (int q = 0; q < 8; ++q) s += PS[(q * 5 + j) * 64 + c];
        ((float*)(P.ws + WS_MOD))[(l * 5 + j) * 6144 + cb * 64 + c] = s;
    }
}

__device__ __forceinline__ void prep_zoh(const Params& P, int task) {
    const int dg = task, tid = otid();
    unsigned char* ws = P.ws;
    if (tid < 64) {
        const int p = tid;
        const float are = P.in[23][dg * 64 + p], aim = P.in[24][dg * 64 + p];
        const float dt = expf(P.in[25][dg]);
        const float mag = expf(are * dt);
        float sn, cs; sincosf(aim * dt, &sn, &cs);
        const float abr = mag * cs, abi = mag * sn;
        const float den = are * are + aim * aim, nr = abr - 1.0f, ni = abi;
        const float kr = (nr * are + ni * aim) / den, ki = (ni * are - nr * aim) / den;
        float* sa = (float*)(ws + WS_SSA) + (size_t)(dg * 64 + p) * 2; sa[0] = abr; sa[1] = abi;
        float pr = abr, pi = abi;
#pragma unroll
        for (int i = 0; i < 6; ++i) { const float tr = pr * pr - pi * pi, ti = 2.0f * pr * pi; pr = tr; pi = ti; }
        float* s64 = (float*)(ws + WS_SSA64) + (size_t)(dg * 64 + p) * 2; s64[0] = pr; s64[1] = pi;
        bf16_t* bm = (bf16_t*)(ws + WS_BM);
        for (int c = 0; c < 16; ++c) {
            const float bre = P.in[26][(size_t)(dg * 64 + p) * 16 + c], bim = P.in[27][(size_t)(dg * 64 + p) * 16 + c];
            const float bbr = kr * bre - ki * bim, bbi = kr * bim + ki * bre;
            bm[((size_t)((dg * 2 + 0) * 64 + p)) * 16 + c] = (bf16_t)(pk2(bbr, 0.f) & 0xffff);
            bm[((size_t)((dg * 2 + 1) * 64 + p)) * 16 + c] = (bf16_t)(pk2(bbi, 0.f) & 0xffff);
        }
    }
    bf16_t* cm = (bf16_t*)(ws + WS_CM);
    for (int i = tid; i < 2048; i += NTHREADS) {
        const int c = i >> 7, pp = i & 127;
        const float v = pp < 64 ? P.in[28][(size_t)(dg * 16 + c) * 64 + pp] : -P.in[29][(size_t)(dg * 16 + c) * 64 + (pp - 64)];
        cm[(size_t)(dg * 16 + c) * 128 + pp] = (bf16_t)(pk2(v, 0.f) & 0xffff);
    }
}

__device__ __forceinline__ void prep_rope(const Params& P) {
    float* rp = (float*)(P.ws + WS_ROPE);
    for (int idx = otid(); idx < 1024; idx += NTHREADS) {
        const int pos = idx >> 4, i = idx & 15;
        const float f = powf(10000.0f, -(float)i / 16.0f);
        float sn, cs; sincosf((float)pos * f, &sn, &cs);
        rp[idx * 2] = cs; rp[idx * 2 + 1] = sn;
    }
    float mx = 0.f;
    for (int i = otid(); i < 8 * 465; i += NTHREADS) mx = fmaxf(mx, fabsf(P.in[22][i]));
    atomicMax((unsigned*)(P.ws + WS_KMAX) + 2, __float_as_uint(mx));
}

__device__ __forceinline__ void prep_cache(const Params& P, int task) {
    const float* src; bf16_t* dst; int t = task;
    if (t < 128) { src = P.in[2]; dst = (bf16_t*)(P.ws + WS_NAK); }
    else if (t < 256) { src = P.in[3]; dst = (bf16_t*)(P.ws + WS_NAV); t -= 128; }
    else if (t < 320) { src = P.in[6]; dst = (bf16_t*)(P.ws + WS_GQK); t -= 256; }
    else { src = P.in[7]; dst = (bf16_t*)(P.ws + WS_GQV); t -= 320; }
    const size_t e = (size_t)t * 4096 + otid() * 8;
    const f32x4 a = *(const f32x4*)(src + e), b = *(const f32x4*)(src + e + 4);
    u32x4 o; o.x = pk2(a[0], a[1]); o.y = pk2(a[2], a[3]); o.z = pk2(b[0], b[1]); o.w = pk2(b[2], b[3]);
    *(u32x4*)(dst + e) = o;
    if (task < 128 || (task >= 256 && task < 320)) {
        float ss = (a[0] * a[0] + a[1] * a[1]) + (a[2] * a[2] + a[3] * a[3]) + (b[0] * b[0] + b[1] * b[1]) + (b[2] * b[2] + b[3] * b[3]);
        ss += __shfl_xor(ss, 1); ss += __shfl_xor(ss, 2); ss += __shfl_xor(ss, 4);
        if ((threadIdx.x & 7) == 0) atomicMax((unsigned*)(P.ws + WS_KMAX) + (task < 128 ? 0 : 1), __float_as_uint(ss));
    }
}

__device__ __forceinline__ void norm_phase(const Params& P, int l, int which, const float* xc, const float* xl) {
    const float* gam = P.in[which == 0 ? 10 : 11] + l * DM;
    const float* mod = (const float*)(P.ws + WS_MOD) + (size_t)l * 5 * 6144;
    const int shoff = which == 0 ? 0 : 3072, scoff = shoff + 1024;
    bf16_t* H = (bf16_t*)(P.ws + WS_H);
    const int tid_ = otid(); const int lane = tid_ & 63, wv = tid_ >> 6;
    const int stride = gridDim.x * 8;
    int row = blockIdx.x * 8 + wv;
    f32x4 v[4], vn[4];
    if (row < NTOK) {
        const float* x = row < NCTX ? xc + (size_t)row * DM : xl + (size_t)(row - NCTX) * DM;
#pragma unroll
        for (int i = 0; i < 4; ++i) v[i] = *(const f32x4*)(x + lane * 4 + 256 * i);
    }
    for (; row < NTOK; row += stride) {
        const int nrow = row + stride;
        if (nrow < NTOK) {
            const float* xn_ = nrow < NCTX ? xc + (size_t)nrow * DM : xl + (size_t)(nrow - NCTX) * DM;
#pragma unroll
            for (int i = 0; i < 4; ++i) vn[i] = *(const f32x4*)(xn_ + lane * 4 + 256 * i);
        }
        const float* mc = mod + condof(row) * 6144;
        float ss = 0.f;
#pragma unroll
        for (int i = 0; i < 4; ++i) ss += v[i][0] * v[i][0] + v[i][1] * v[i][1] + v[i][2] * v[i][2] + v[i][3] * v[i][3];
        ss = wave_sum(ss);
        const float rstd = rsqrtf(ss * (1.0f / 1024.0f) + EPSN);
#pragma unroll
        for (int i = 0; i < 4; ++i) {
            const int c = lane * 4 + 256 * i;
            const f32x4 gg = *(const f32x4*)(gam + c), sc = *(const f32x4*)(mc + scoff + c), sh = *(const f32x4*)(mc + shoff + c);
            const f32x4 h = v[i] * rstd * gg * (sc + 1.0f) + sh;
            u32x2 o; o.x = pk2(h[0], h[1]); o.y = pk2(h[2], h[3]);
            *(u32x2*)(H + (size_t)row * DM + c) = o;
        }
#pragma unroll
        for (int i = 0; i < 4; ++i) v[i] = vn[i];
    }
}

__device__ __forceinline__ void conv_phase(const Params& P, int l, int row0, int nrows) {
    bf16_t* GV = (bf16_t*)(P.ws + WS_GV);
    const float* cw = P.in[15] + (size_t)l * 3 * DFF;
    const float* cb = P.in[16] + (size_t)l * DFF;
    const long nitem = (long)nrows * 352;
    for (long it = (long)blockIdx.x * NTHREADS + otid(); it < nitem; it += (long)gridDim.x * NTHREADS) {
        const int r = (int)(it / 352), f = (int)(it % 352) * 8;
        const int row = row0 + r;
        int t, L;
        if (row < NCTX) { t = row & 255; L = 256; } else { t = (row - NCTX) & 4095; L = 4096; }
        bf16_t* gp = GV + (size_t)r * 5632 + f;
        const u32x4 g1 = *(const u32x4*)gp;
        u32x4 g0 = (u32x4){0, 0, 0, 0}, g2 = (u32x4){0, 0, 0, 0};
        if (t > 0) g0 = *(const u32x4*)(gp - 5632);
        if (t < L - 1) g2 = *(const u32x4*)(gp + 5632);
        const u32x4 vv = *(const u32x4*)(gp + DFF);
        u32x4 o;
#pragma unroll
        for (int q = 0; q < 4; ++q) {
            const int fa = f + 2 * q, fb = fa + 1;
            const float ca = cw[fa] * bflo(g0[q]) + cw[DFF + fa] * bflo(g1[q]) + cw[2 * DFF + fa] * bflo(g2[q]) + cb[fa];
            const float cbv = cw[fb] * bfhi(g0[q]) + cw[DFF + fb] * bfhi(g1[q]) + cw[2 * DFF + fb] * bfhi(g2[q]) + cb[fb];
            o[q] = pk2(siluf(ca) * bflo(vv[q]), siluf(cbv) * bfhi(vv[q]));
        }
        *(u32x4*)(gp + DFF) = o;
    }
}

#define XB_TMO      128
#define XB_XCNT(j)  (256  + 64 * (j))
#define XB_XSUB(j)  (1280 + 64 * (j))
#define XB_XGEN(j)  (2304 + 64 * (j))
#define XB_TOP      3328
#define XB_TOPGEN   3392
#define XCD_BAR_WORDS 3456
#define XB_SPIN_CAP (1u << 18)
__device__ __forceinline__ unsigned xb_ld(unsigned* p)              { return __hip_atomic_load(p, __ATOMIC_RELAXED, __HIP_MEMORY_SCOPE_AGENT); }
__device__ __forceinline__ unsigned xb_add(unsigned* p, unsigned v) { return __hip_atomic_fetch_add(p, v, __ATOMIC_RELAXED, __HIP_MEMORY_SCOPE_AGENT); }
__device__ __forceinline__ unsigned xb_xcc_id() { return (unsigned)__builtin_amdgcn_s_getreg((3 << 11) | 20) & 0xFu; }
#define XB_SPIN(cond, bar) do { unsigned _sp = 0; while (cond) { __builtin_amdgcn_s_sleep(1); \
    if ((++_sp & 255u) == 0u) { if (xb_ld(&(bar)[XB_TMO])) break; if (_sp > XB_SPIN_CAP) { atomicAdd(&(bar)[XB_TMO], 1u); break; } } } } while (0)
struct XcdBarrier { unsigned* bar; unsigned x; volatile LAS unsigned* st; };
__device__ __forceinline__ XcdBarrier xcd_barrier_post(unsigned* bar, volatile LAS unsigned* st) {
    XcdBarrier b; b.bar = bar; b.x = xb_xcc_id(); b.st = st;
    if (threadIdx.x == 0) (void)xb_add(&bar[XB_XCNT(b.x)], 1u);
    return b;
}
__device__ __forceinline__ void xcd_barrier_complete(unsigned* bar, unsigned x, unsigned& nloc, unsigned& nx) {
    const unsigned G = gridDim.x * gridDim.y * gridDim.z;
    unsigned sum, cnt, mine, sp = 0u;
    for (;;) {
        sum = 0u; cnt = 0u; mine = 0u;
#pragma unroll
        for (unsigned j = 0; j < 16; ++j) { const unsigned c = xb_ld(&bar[XB_XCNT(j)]); sum += c; cnt += (c > 0u) ? 1u : 0u; mine = (j == x) ? c : mine; }
        if (sum == G) break;
        __builtin_amdgcn_s_sleep(1);
        if ((++sp & 255u) == 0u) { if (xb_ld(&bar[XB_TMO])) break; if (sp > XB_SPIN_CAP) { atomicAdd(&bar[XB_TMO], 1u); break; } }
    }
    nloc = mine > 0u ? mine : 1u; nx = cnt > 0u ? cnt : 1u;
}
__device__ __forceinline__ void xcd_barrier(const XcdBarrier& b) {
    asm volatile("s_waitcnt vmcnt(0)" ::: "memory");
    __syncthreads();
    if (threadIdx.x == 0) {
        unsigned* bar = b.bar;
        __builtin_amdgcn_s_waitcnt(0);
        unsigned nloc = b.st[0], nx = b.st[1];
        if (nloc == 0u) { xcd_barrier_complete(bar, b.x, nloc, nx); b.st[0] = nloc; b.st[1] = nx; }
        const unsigned old = xb_add(&bar[XB_XSUB(b.x)], 1u);
        const unsigned gen = old / nloc;
        if (old + 1u == (gen + 1u) * nloc) {
            __builtin_amdgcn_fence(__ATOMIC_RELEASE, "agent");
            asm volatile("s_waitcnt vmcnt(0)" ::: "memory");
            const unsigned og = xb_add(&bar[XB_TOP], 1u);
            const unsigned tg = og / nx;
            if (og + 1u == (tg + 1u) * nx) xb_add(&bar[XB_TOPGEN], 1u);
            else XB_SPIN(xb_ld(&bar[XB_TOPGEN]) == tg, bar);
            __builtin_amdgcn_fence(__ATOMIC_ACQUIRE, "agent");
            xb_add(&bar[XB_XGEN(b.x)], 1u);
            asm volatile("s_waitcnt vmcnt(0)" ::: "memory");
        } else {
            XB_SPIN(xb_ld(&bar[XB_XGEN(b.x)]) == gen, bar);
            __builtin_amdgcn_fence(__ATOMIC_ACQUIRE, "agent");
            asm volatile("s_waitcnt vmcnt(0)" ::: "memory");
        }
    }
    __syncthreads();
}

constexpr int NPH = 17;
constexpr int PREP_MOD = 192, PREP_Z = 64, PREP_R = 1, PREP_C = 384;

#ifndef REP
#define REP 0
#endif
__device__ __forceinline__ int nrep(int ph) {
    int r = 1;
    const int l = ph >= 10 ? 1 : 0, lp = l == 0 ? ph - 1 : ph - 10;
    if ((REP & 16) && ph == 0) r = 2;
    if (ph > 0) {
        const bool up = l == 0 ? (lp == 7) : (lp == 5);
        if ((REP & 1) && up) r = 2;
        if ((REP & 2) && lp == 2 && l == 1) r = 2;
        if ((REP & 32) && lp == 2 && l == 0) r = 2;
        const bool nrm = lp == 0 || (l == 0 ? lp == 6 : lp == 4);
        if ((REP & 4) && nrm) r = 2;
        if ((REP & 64) && l == 0 && lp == 3) r = 2;
    }
    return r;
}
__global__ void __launch_bounds__(NTHREADS, 2) mega(Params P) {
    unsigned char* ws = P.ws;
    bf16_t* H = (bf16_t*)(ws + WS_H);
    bf16_t* MIX = H;
    bf16_t* QKV = (bf16_t*)(ws + WS_QKV);
    bf16_t* Ub = (bf16_t*)(ws + WS_U);
    bf16_t* GV = (bf16_t*)(ws + WS_GV);
    const float* MOD = (const float*)(ws + WS_MOD);
    float* out = P.out;
    extern __shared__ __attribute__((aligned(16))) unsigned char smem_k[];
    volatile LAS unsigned* bst = (volatile LAS unsigned*)(smem_k + 131072);
    if (threadIdx.x < 2) bst[threadIdx.x] = 0u;
    __syncthreads();
    const XcdBarrier xb = xcd_barrier_post((unsigned*)(ws + WS_BAR), bst);
    for (int ph = P.ph_lo; ph < P.ph_hi; ++ph) {
        if (ph > P.ph_lo) { if (P.use_cg) cg::this_grid().sync(); else xcd_barrier(xb); if (REP & 8) xcd_barrier(xb); }
        for (int rep = 0; rep < nrep(ph); ++rep) {
        if (ph == 0 && !EN_MISC) continue;
        if (ph == 0) {
            constexpr int tot = PREP_MOD + PREP_Z + PREP_R + PREP_C + 736;
            for (int t = blockIdx.x; t < tot; t += gridDim.x) {
                int q = t;
                if (q < PREP_MOD) { prep_mod(P, q); continue; } q -= PREP_MOD;
                if (q < PREP_Z) { prep_zoh(P, q); continue; } q -= PREP_Z;
                if (q < PREP_R) { prep_rope(P); continue; } q -= PREP_R;
                if (q < PREP_C) { prep_cache(P, q); continue; } q -= PREP_C;
                if (q < 128) { prep_wtile<false>(P.in[18], (bf16_t*)(ws + WS_WINE), 1024, 2048, q); continue; } q -= 128;
                if (q < 64) { prep_wtile<false>(P.in[19], (bf16_t*)(ws + WS_WOUTE), 1024, 1024, q); continue; } q -= 64;
                if (q < 16) { prep_wtile<false>(P.in[31], (bf16_t*)(ws + WS_WGLU), 512, 512, q); continue; } q -= 16;
                if (q < 352) { prep_wtile<true>(P.in[14], (bf16_t*)(ws + WS_WUP), 1024, 5632, q); continue; } q -= 352;
                prep_wtile<false>(P.in[17], (bf16_t*)(ws + WS_WDOWN), 2816, 1024, q);
            }
            continue;
        }
        const int l = ph >= 10 ? 1 : 0;
        const int lp = l == 0 ? ph - 1 : ph - 10;
        const float* modl = MOD + (size_t)l * 5 * 6144;
        const float* xc0 = P.in[0]; const float* xl0 = P.in[1];
        const float* xcd = out + O_Y; const float* xld = out + O_Y + (size_t)NCTX * DM;
        if (lp == 0) {
            if (l == 0) norm_phase(P, 0, 0, xc0, xl0); else norm_phase(P, 1, 0, xcd, xld);
        } else if (lp == 1) {
            if (l == 0) {
                EpiInEven e{QKV, Ub, P.in[20], P.in[21], out + O_NAK, out + O_NAV};
                run_gemm<0>(H, DM, (const bf16_t*)(ws + WS_WINE), DM, 2048, 0, NTOK, e);
            } else {
                EpiInOdd e{QKV, P.in[35], P.in[36], (const float*)(ws + WS_ROPE), out + O_GQK, out + O_GQV};
                run_gemm<1>(H, DM, (const bf16_t*)(ws + WS_WINO), DM, 1536, 0, NTOK, e);
            }
        } else if (lp == 2) {
            if (l == 0) {
                for (int t = blockIdx.x; t < 256 + 128 + 640; t += gridDim.x) {
                    if (t < 256) {
                        const int r8 = t & 7, h = (t >> 3) & 7, b = t >> 6;
                        const int r0 = r8 * 8;
                        const int rb0 = min(max(r0 - 4, 0), 56), rb1 = min(max(r0 + 7 - 4, 0), 56) + 7;
                        const size_t tok0 = (size_t)NCTX + (size_t)b * 4096;
                        AttnUnit u;
                        u.Q = QKV + (tok0 + r0 * 64) * 1536 + h * 64; u.qs = 1536;
                        u.K1 = QKV + (tok0 + rb0 * 64) * 1536 + 512 + h * 64; u.V1 = QKV + (tok0 + rb0 * 64) * 1536 + 1024 + h * 64; u.s1 = 1536; u.n1 = rb1 - rb0 + 1;
                        u.K2 = (const bf16_t*)(ws + WS_NAK) + (size_t)b * 256 * 512 + h * 64; u.V2 = (const bf16_t*)(ws + WS_NAV) + (size_t)b * 256 * 512 + h * 64; u.s2 = 512; u.n2 = 4;
                        u.O = MIX + (tok0 + r0 * 64) * DM + h * 64; u.os = DM;
                        u.kind = 1; u.r0 = r0; u.rb0 = rb0; u.rpb = P.in[22] + h * 465;
                        u.gq = P.in[20]; u.gk = P.in[21]; u.kmax = (const unsigned*)(ws + WS_KMAX); u.kw = 0;
                        if (EN_ATT) attn_unit64<true>(u);
                    } else if (t < 384) {
                        const int q = t - 256, h = q & 7, s = q >> 3;
                        const size_t tok0 = (size_t)s * 256;
                        AttnUnit u;
                        u.Q = QKV + tok0 * 1536 + h * 64; u.qs = 1536;
                        u.K1 = QKV + tok0 * 1536 + 512 + h * 64; u.V1 = QKV + tok0 * 1536 + 1024 + h * 64; u.s1 = 1536; u.n1 = 4;
                        u.K2 = u.K1; u.V2 = u.V1; u.s2 = 1536; u.n2 = 0;
                        u.O = MIX + tok0 * DM + h * 64; u.os = DM;
                        u.kind = 0; u.r0 = 0; u.rb0 = 0; u.rpb = P.in[22];
                        if (EN_ATT) attn_unit_old(u);
                    } else {
                        if (EN_SSM) ssm_task<false>(P, t - 384);
                    }
                }
            } else {
                for (int t = blockIdx.x; t < 512 + 256; t += gridDim.x) {
                    AttnUnit u;
                    if (t < 512) {
                        const int qt = t & 7, h = (t >> 3) & 15, b = t >> 7, kvh = h >> 2;
                        const size_t tok0 = (size_t)NCTX + (size_t)b * 4096;
                        u.Q = QKV + (tok0 + qt * 512) * 1536 + h * 64; u.qs = 1536;
                        u.K1 = QKV + tok0 * 1536 + 1024 + kvh * 64; u.V1 = QKV + tok0 * 1536 + 1280 + kvh * 64; u.s1 = 1536; u.n1 = 64;
                        u.K2 = (const bf16_t*)(ws + WS_GQK) + (size_t)b * 256 * 256 + kvh * 64; u.V2 = (const bf16_t*)(ws + WS_GQV) + (size_t)b * 256 * 256 + kvh * 64; u.s2 = 256; u.n2 = 4;
                        u.O = MIX + (tok0 + qt * 512) * DM + h * 64; u.os = DM;
                        u.kind = 0; u.r0 = 0; u.rb0 = 0; u.rpb = P.in[22];
                        u.gq = P.in[35]; u.gk = P.in[36]; u.kmax = (const unsigned*)(ws + WS_KMAX); u.kw = 1;
                        if (EN_ATT) attn_unit64<false>(u);
                    } else {
                        const int q = t - 512, h = q & 15, s = q >> 4, kvh = h >> 2;
                        const size_t tok0 = (size_t)s * 256;
                        u.Q = QKV + tok0 * 1536 + h * 64; u.qs = 1536;
                        u.K1 = QKV + tok0 * 1536 + 1024 + kvh * 64; u.V1 = QKV + tok0 * 1536 + 1280 + kvh * 64; u.s1 = 1536; u.n1 = 4;
                        u.K2 = u.K1; u.V2 = u.V1; u.s2 = 1536; u.n2 = 0;
                        u.O = MIX + tok0 * DM + h * 64; u.os = DM;
                        u.kind = 0; u.r0 = 0; u.rb0 = 0; u.rpb = P.in[22];
                        if (EN_ATT) attn_unit_old(u);
                    }
                }
            }
        } else if (lp == 3) {
            if (l == 0) {
                carry_phase(P);
                xcd_barrier(xb);
                for (int t = blockIdx.x; t < 640; t += gridDim.x) { __syncthreads(); if (EN_SSM) ssm_task<true>(P, t); }
                if (blockIdx.x >= 128 && EN_MISC) {
                    for (int q0 = (int)blockIdx.x - 128; q0 < 688; q0 += 128) {
                        int q = q0;
                        if (q < 96) { prep_wtile<false>(P.in[33], (bf16_t*)(ws + WS_WINO), 1024, 1536, q); continue; } q -= 96;
                        if (q < 64) { prep_wtile<false>(P.in[34], (bf16_t*)(ws + WS_WOUTO), 1024, 1024, q); continue; } q -= 64;
                        if (q < 352) { prep_wtile<true>(P.in[14] + (size_t)1024 * 5632, (bf16_t*)(ws + WS_WUP) + (size_t)5632 * 1024, 1024, 5632, q); continue; } q -= 352;
                        prep_wtile<false>(P.in[17] + (size_t)2816 * 1024, (bf16_t*)(ws + WS_WDOWN) + (size_t)1024 * 2816, 2816, 1024, q);
                    }
                }
            } else {
                EpiResid1 e{xcd, xld, out + O_Y, modl, 2048};
                run_gemm_n128(MIX, DM, (const bf16_t*)(ws + WS_WOUTO), DM, 1024, e);
            }
        } else if (l == 0 && lp == 4) {
            EpiGlu e{(const bf16_t*)(ws + WS_YG), MIX, P.in[32]};
            run_gemm<3>((const bf16_t*)(ws + WS_YG), 512, (const bf16_t*)(ws + WS_WGLU), 512, 512, 0, NTOK, e);
        } else if (l == 0 && lp == 5) {
            EpiResid1 e{xc0, xl0, out + O_Y, modl, 2048};
            run_gemm_n128(MIX, DM, (const bf16_t*)(ws + WS_WOUTE), DM, 1024, e);
        } else {
            const int fp = l == 0 ? lp - 6 : lp - 4;
            bf16_t* ACT = (bf16_t*)(ws + WS_GV);
            if (fp == 0) {
                norm_phase(P, l, 1, xcd, xld);
            } else if (fp == 1) {
                EpiUpConv e{ACT, P.in[15] + (size_t)l * 3 * DFF, P.in[16] + (size_t)l * DFF};
                run_gemm_up(H, (const bf16_t*)(ws + WS_WUP) + (size_t)l * 5632 * 1024, e);
            } else {
                EpiResid1 e{xcd, xld, out + O_Y, modl, 5120};
                run_gemm_n128(ACT, DFF, (const bf16_t*)(ws + WS_WDOWN) + (size_t)l * 1024 * 2816, DFF, 1024, e);
            }
        }
        }
    }
}

extern "C" void kernel_launch(void* const* d_in, const int* in_sizes, int n_in, void* d_out, int out_size, void* d_ws, size_t ws_size, hipStream_t stream) {
    static int grid = 0;
    if (grid == 0) {
        int dev = 0, cus = 0, per_cu = 0;
        hipGetDevice(&dev);
        hipDeviceGetAttribute(&cus, hipDeviceAttributeMultiprocessorCount, dev);
        hipFuncSetAttribute((const void*)mega, hipFuncAttributeMaxDynamicSharedMemorySize, LDS_BYTES);
        hipOccupancyMaxActiveBlocksPerMultiprocessor(&per_cu, (const void*)mega, NTHREADS, LDS_BYTES);
        if (per_cu < 1) per_cu = 1;
        grid = cus * per_cu;
        if (n_in != 37 || ws_size < 240 * MiB) fprintf(stderr, "kernel_launch: unexpected n_in %d / ws %zu\n", n_in, ws_size);
    }
    Params p{};
    for (int i = 0; i < 37; ++i) p.in[i] = (const float*)d_in[i];
    p.out = (float*)d_out; p.ws = (unsigned char*)d_ws;
    p.use_cg = 0; p.pad = 0;
    (void)hipMemsetAsync((unsigned char*)d_ws + WS_BAR, 0, XCD_BAR_WORDS * 4 + 256, stream);
#if COOP
    p.ph_lo = 0; p.ph_hi = NPH;
    void* args[] = {&p};
    hipError_t e = hipLaunchCooperativeKernel((const void*)mega, dim3(grid), dim3(NTHREADS), args, LDS_BYTES, stream);
    if (e != hipSuccess) fprintf(stderr, "cooperative launch failed: %s (grid %d)\n", hipGetErrorString(e), grid);
#else
    for (int ph = 0; ph < NPH; ++ph) {
        p.ph_lo = ph; p.ph_hi = ph + 1;
        hipLaunchKernelGGL(mega, dim3(grid), dim3(NTHREADS), LDS_BYTES, stream, p);
    }
#endif
}
```
